# Optimizing an MI355X kernel written in HIP

```python
import math
import jax, jax.numpy as jnp
from jax import lax
import numpy as np

D_MODEL = 2048
BATCH = 1
SEQ = 8192
DEPTH = 2
DEC_BATCH = 32
DEC_SEQ = 16
PAST_LEN = 2048

CHUNK = 64
N_A = DEPTH // 2
N_B = DEPTH - N_A
SSM_WIDTH = D_MODEL
SSM_GROUP = 16
SSM_GROUPS = SSM_WIDTH // SSM_GROUP
SSM_STATE = 64
N_HEADS = 8
HEAD_DIM = D_MODEL // (2 * N_HEADS)
ATTN_WIDTH = 2 * N_HEADS * HEAD_DIM
Q_BLOCK = 128
ROPE_THETA = 10000.0
EPS = 1e-6
NEG = -1e30

kernel_name = 'yoco_s5_diffattn_streaming_step'


def rmsnorm(x, g):
    xf = x.astype(jnp.float32)
    y = xf * lax.rsqrt(jnp.mean(xf * xf, axis=-1, keepdims=True) + EPS) * g.astype(jnp.float32)
    return y.astype(x.dtype)


def rope(x, pos):
    d = x.shape[-1]
    inv_freq = ROPE_THETA ** (-jnp.arange(0, d, 2, dtype=jnp.float32) / d)
    ang = pos.astype(jnp.float32)[:, None] * inv_freq[None, :]
    c = jnp.cos(ang)[:, None, :]
    s = jnp.sin(ang)[:, None, :]
    xf = x.astype(jnp.float32)
    x1, x2 = xf[..., : d // 2], xf[..., d // 2:]
    return jnp.concatenate([x1 * c - x2 * s, x1 * s + x2 * c], axis=-1).astype(x.dtype)


def zoh(lam_re, lam_im, log_dt, b_re, b_im):
    lam_re = lam_re.astype(jnp.float32)
    lam_im = lam_im.astype(jnp.float32)
    dt = jnp.exp(log_dt.astype(jnp.float32))[:, None]
    zr, zi = lam_re * dt, lam_im * dt
    mag = jnp.exp(zr)
    abar_re, abar_im = mag * jnp.cos(zi), mag * jnp.sin(zi)
    n_re, n_im = abar_re - 1.0, abar_im
    den = lam_re * lam_re + lam_im * lam_im
    coef_re = (n_re * lam_re + n_im * lam_im) / den
    coef_im = (n_im * lam_re - n_re * lam_im) / den
    b_re = b_re.astype(jnp.float32)
    b_im = b_im.astype(jnp.float32)
    bb_re = coef_re[..., None] * b_re - coef_im[..., None] * b_im
    bb_im = coef_re[..., None] * b_im + coef_im[..., None] * b_re
    return abar_re, abar_im, bb_re, bb_im


def combine(e1, e2):
    a1r, a1i, b1r, b1i = e1
    a2r, a2i, b2r, b2i = e2
    return (a2r * a1r - a2i * a1i,
            a2r * a1i + a2i * a1r,
            a2r * b1r - a2i * b1i + b2r,
            a2r * b1i + a2i * b1r + b2i)


def ssm_block(u, h_re, h_im, abar_re, abar_im, bb_re, bb_im, c_re, c_im):
    bsz, l, _ = u.shape
    ug = u.reshape(bsz, l, SSM_GROUPS, SSM_GROUP)
    bu_re = jnp.einsum('gpc,blgc->blgp', bb_re, ug)
    bu_im = jnp.einsum('gpc,blgc->blgp', bb_im, ug)
    bu_re = bu_re.at[:, 0].add(abar_re * h_re - abar_im * h_im)
    bu_im = bu_im.at[:, 0].add(abar_re * h_im + abar_im * h_re)
    a_re = jnp.broadcast_to(abar_re, bu_re.shape)
    a_im = jnp.broadcast_to(abar_im, bu_im.shape)
    _, _, s_re, s_im = lax.associative_scan(combine, (a_re, a_im, bu_re, bu_im), axis=1)
    y = jnp.einsum('gcp,blgp->blgc', c_re, s_re) - jnp.einsum('gcp,blgp->blgc', c_im, s_im)
    return y.reshape(bsz, l, SSM_WIDTH), s_re[:, -1], s_im[:, -1]


def mixer_a(x, h0_re, h0_im, g, w_in, lam_re, lam_im, log_dt, b_re, b_im, c_re, c_im, d_skip, w_glu, w_out):
    bsz, l, _ = x.shape
    uz = rmsnorm(x, g) @ w_in
    u, z = uz[..., :SSM_WIDTH], uz[..., SSM_WIDTH:]
    abar_re, abar_im, bb_re, bb_im = zoh(lam_re, lam_im, log_dt, b_re, b_im)
    c_re = c_re.astype(jnp.float32)
    c_im = c_im.astype(jnp.float32)
    uf = u.astype(jnp.float32)
    blk = CHUNK if l % CHUNK == 0 else l
    nb = l // blk
    u_blocks = jnp.moveaxis(uf.reshape(bsz, nb, blk, SSM_WIDTH), 1, 0)

    def step(carry, ub):
        y, hr, hi = ssm_block(ub, carry[0], carry[1], abar_re, abar_im, bb_re, bb_im, c_re, c_im)
        return (hr, hi), y

    (hr, hi), ys = lax.scan(step, (h0_re.astype(jnp.float32), h0_im.astype(jnp.float32)), u_blocks)
    y = jnp.moveaxis(ys, 0, 1).reshape(bsz, l, SSM_WIDTH) + d_skip.astype(jnp.float32) * uf
    y = jax.nn.gelu(y)
    y = y * jax.nn.sigmoid(y @ w_glu.astype(jnp.float32))
    o = y.astype(x.dtype) * jax.nn.silu(z)
    return x + o @ w_out, hr, hi


def shared_kv(x, pos, g, w_kv):
    bsz, l, _ = x.shape
    kv = rmsnorm(x, g) @ w_kv
    k = rope(kv[..., :ATTN_WIDTH].reshape(bsz, l, 2 * N_HEADS, HEAD_DIM), pos)
    k = k.reshape(bsz, l, N_HEADS, 2 * HEAD_DIM)
    v = kv[..., ATTN_WIDTH:].reshape(bsz, l, N_HEADS, 2 * HEAD_DIM)
    return k, v


def diff_attend(q, k, v, q_pos, k_pos, lam):
    bsz, lk = k.shape[:2]
    kk = k.reshape(bsz, lk, N_HEADS, 2, HEAD_DIM).astype(jnp.float32)
    s = jnp.einsum('bqhnd,bkhnd->bnhqk', q.astype(jnp.float32), kk) * (HEAD_DIM ** -0.5)
    mask = (k_pos[None, :] // CHUNK) <= (q_pos[:, None] // CHUNK)
    p = jax.nn.softmax(jnp.where(mask, s, NEG), axis=-1)
    attn = p[:, 0] - lam * p[:, 1]
    return jnp.einsum('bhqk,bkhe->bqhe', attn, v.astype(jnp.float32))


def attend(q, k, v, q_pos, k_pos, lam):
    bsz, l = q.shape[:2]
    if l > Q_BLOCK and l % Q_BLOCK == 0:
        nb = l // Q_BLOCK
        qb = jnp.moveaxis(q.reshape(bsz, nb, Q_BLOCK, N_HEADS, 2, HEAD_DIM), 1, 0)
        pb = q_pos.reshape(nb, Q_BLOCK)
        ob = lax.map(lambda a: diff_attend(a[0], k, v, a[1], k_pos, lam), (qb, pb))
        return jnp.moveaxis(ob, 0, 1).reshape(bsz, l, N_HEADS, 2 * HEAD_DIM)
    return diff_attend(q, k, v, q_pos, k_pos, lam)


def mixer_b(x, k, v, q_pos, k_pos, g, w_in, lq1, lk1, lq2, lk2, subln, w_out, lambda_init):
    bsz, l, _ = x.shape
    qz = rmsnorm(x, g) @ w_in
    q = rope(qz[..., :ATTN_WIDTH].reshape(bsz, l, 2 * N_HEADS, HEAD_DIM), q_pos)
    q = q.reshape(bsz, l, N_HEADS, 2, HEAD_DIM)
    z = qz[..., ATTN_WIDTH:]
    lam = (jnp.exp(jnp.sum(lq1.astype(jnp.float32) * lk1.astype(jnp.float32)))
           - jnp.exp(jnp.sum(lq2.astype(jnp.float32) * lk2.astype(jnp.float32))) + lambda_init)
    o = attend(q, k, v, q_pos, k_pos, lam)
    o = rmsnorm(o, subln) * (1.0 - lambda_init)
    o = o.reshape(bsz, l, ATTN_WIDTH).astype(x.dtype) * jax.nn.silu(z)
    return x + o @ w_out


def trunk(x, pos, ssm_re, ssm_im, past_k, past_v, a_params, b_params, kv_norm, w_kv, final_norm):
    (a_norm, a_w_in, a_lambda_re, a_lambda_im, a_log_dt, a_b_re, a_b_im,
     a_c_re, a_c_im, a_d, a_w_glu, a_w_out) = a_params
    (b_norm, b_w_in, b_lambda_q1, b_lambda_k1, b_lambda_q2, b_lambda_k2, b_subln, b_w_out) = b_params
    re_out, im_out = [], []
    for i in range(N_A):
        x, hr, hi = mixer_a(x, ssm_re[:, i], ssm_im[:, i], a_norm[i], a_w_in[i], a_lambda_re[i], a_lambda_im[i],
                            a_log_dt[i], a_b_re[i], a_b_im[i], a_c_re[i], a_c_im[i], a_d[i], a_w_glu[i], a_w_out[i])
        re_out.append(hr.astype(ssm_re.dtype))
        im_out.append(hi.astype(ssm_im.dtype))
    k_new, v_new = shared_kv(x, pos, kv_norm, w_kv)
    if past_k is None:
        k_all, v_all, k_pos = k_new, v_new, pos
    else:
        k_all = jnp.concatenate([past_k.astype(k_new.dtype), k_new], axis=1)
        v_all = jnp.concatenate([past_v.astype(v_new.dtype), v_new], axis=1)
        k_pos = jnp.arange(past_k.shape[1] + x.shape[1], dtype=jnp.int32)
    for j in range(N_B):
        lambda_init = 0.8 - 0.6 * math.exp(-0.3 * (N_A + j))
        x = mixer_b(x, k_all, v_all, pos, k_pos, b_norm[j], b_w_in[j], b_lambda_q1[j], b_lambda_k1[j],
                    b_lambda_q2[j], b_lambda_k2[j], b_subln[j], b_w_out[j], lambda_init)
    return rmsnorm(x, final_norm), jnp.stack(re_out, axis=1), jnp.stack(im_out, axis=1), k_new, v_new


def setup_inputs(seed: int = 0) -> dict:
    key = jax.random.key(seed)
    ks = jax.random.split(key, 32)
    f32 = jnp.float32
    nrm = lambda k, shape, s: jax.random.normal(k, shape, f32) * s
    lam_im = jnp.broadcast_to(math.pi * jnp.arange(SSM_STATE, dtype=f32), (N_A, SSM_GROUPS, SSM_STATE))
    return {
        'x_prompt': nrm(ks[0], (BATCH, SEQ, D_MODEL), 1.0),
        'x_sample': nrm(ks[1], (DEC_BATCH, DEC_SEQ, D_MODEL), 1.0),
        'state_ssm_re': nrm(ks[2], (DEC_BATCH, N_A, SSM_GROUPS, SSM_STATE), 0.1),
        'state_ssm_im': nrm(ks[3], (DEC_BATCH, N_A, SSM_GROUPS, SSM_STATE), 0.1),
        'cache_k': nrm(ks[4], (DEC_BATCH, PAST_LEN, N_HEADS, 2 * HEAD_DIM), 1.0),
        'cache_v': nrm(ks[5], (DEC_BATCH, PAST_LEN, N_HEADS, 2 * HEAD_DIM), 1.0),
        'a_norm': 1.0 + nrm(ks[6], (N_A, D_MODEL), 0.02),
        'a_w_in': nrm(ks[7], (N_A, D_MODEL, 2 * SSM_WIDTH), D_MODEL ** -0.5),
        'a_lambda_re': -0.5 + nrm(ks[8], (N_A, SSM_GROUPS, SSM_STATE), 0.01),
        'a_lambda_im': lam_im + nrm(ks[9], (N_A, SSM_GROUPS, SSM_STATE), 0.01),
        'a_log_dt': jax.random.uniform(ks[10], (N_A, SSM_GROUPS), f32, math.log(0.001), math.log(0.1)),
        'a_b_re': nrm(ks[11], (N_A, SSM_GROUPS, SSM_STATE, SSM_GROUP), (2 * SSM_GROUP) ** -0.5),
        'a_b_im': nrm(ks[12], (N_A, SSM_GROUPS, SSM_STATE, SSM_GROUP), (2 * SSM_GROUP) ** -0.5),
        'a_c_re': nrm(ks[13], (N_A, SSM_GROUPS, SSM_GROUP, SSM_STATE), (2 * SSM_STATE) ** -0.5),
        'a_c_im': nrm(ks[14], (N_A, SSM_GROUPS, SSM_GROUP, SSM_STATE), (2 * SSM_STATE) ** -0.5),
        'a_d': nrm(ks[15], (N_A, SSM_WIDTH), 1.0),
        'a_w_glu': nrm(ks[16], (N_A, SSM_WIDTH, SSM_WIDTH), SSM_WIDTH ** -0.5),
        'a_w_out': nrm(ks[17], (N_A, SSM_WIDTH, D_MODEL), SSM_WIDTH ** -0.5),
        'kv_norm': 1.0 + nrm(ks[18], (D_MODEL,), 0.02),
        'w_kv': nrm(ks[19], (D_MODEL, 2 * ATTN_WIDTH), D_MODEL ** -0.5),
        'b_norm': 1.0 + nrm(ks[20], (N_B, D_MODEL), 0.02),
        'b_w_in': nrm(ks[21], (N_B, D_MODEL, 2 * ATTN_WIDTH), D_MODEL ** -0.5),
        'b_lambda_q1': nrm(ks[22], (N_B, HEAD_DIM), 0.1),
        'b_lambda_k1': nrm(ks[23], (N_B, HEAD_DIM), 0.1),
        'b_lambda_q2': nrm(ks[24], (N_B, HEAD_DIM), 0.1),
        'b_lambda_k2': nrm(ks[25], (N_B, HEAD_DIM), 0.1),
        'b_subln': 1.0 + nrm(ks[26], (N_B, 2 * HEAD_DIM), 0.02),
        'b_w_out': nrm(ks[27], (N_B, ATTN_WIDTH, D_MODEL), ATTN_WIDTH ** -0.5),
        'final_norm': 1.0 + nrm(ks[28], (D_MODEL,), 0.02),
    }


def reference(x_prompt, x_sample, state_ssm_re, state_ssm_im, cache_k, cache_v,
              a_norm, a_w_in, a_lambda_re, a_lambda_im, a_log_dt, a_b_re, a_b_im, a_c_re, a_c_im,
              a_d, a_w_glu, a_w_out, kv_norm, w_kv, b_norm, b_w_in, b_lambda_q1, b_lambda_k1,
              b_lambda_q2, b_lambda_k2, b_subln, b_w_out, final_norm):
    a_params = (a_norm, a_w_in, a_lambda_re, a_lambda_im, a_log_dt, a_b_re, a_b_im,
                a_c_re, a_c_im, a_d, a_w_glu, a_w_out)
    b_params = (b_norm, b_w_in, b_lambda_q1, b_lambda_k1, b_lambda_q2, b_lambda_k2, b_subln, b_w_out)
    h0 = jnp.zeros((x_prompt.shape[0], N_A, SSM_GROUPS, SSM_STATE), state_ssm_re.dtype)
    pos_p = jnp.arange(x_prompt.shape[1], dtype=jnp.int32)
    y_prompt, re_p, im_p, k_p, v_p = trunk(x_prompt, pos_p, h0, h0, None, None,
                                           a_params, b_params, kv_norm, w_kv, final_norm)
    pos_s = cache_k.shape[1] + jnp.arange(x_sample.shape[1], dtype=jnp.int32)
    y_sample, re_s, im_s, k_s, v_s = trunk(x_sample, pos_s, state_ssm_re, state_ssm_im, cache_k, cache_v,
                                           a_params, b_params, kv_norm, w_kv, final_norm)
    return (y_prompt, y_sample, re_p, im_p, k_p, v_p, re_s, im_s, k_s, v_s)
```

```cpp
#include <hip/hip_runtime.h>
#include <cstdint>
#include <cstdio>
#include <cmath>

constexpr int DM = 2048, SEQ = 8192, DB = 32, DS = 16, PAST = 2048;
constexpr int MP = SEQ, MS = DB * DS, M = MP + MS;
constexpr int NG = 128, NP = 64, GC = 16;
constexpr int NH = 8, HD = 128, AW = 2048;
constexpr float EPS = 1e-6f;
constexpr float LAMBDA_INIT = 0.35550906759096995f;
constexpr float QSCALE = 0.08838834764831845f * 1.4426950408889634f;
constexpr int NSSQ = 32;

constexpr size_t O_YP = 0, O_YS = O_YP + (size_t)MP * DM, O_REP = O_YS + (size_t)MS * DM, O_IMP = O_REP + NG * NP,
                 O_KP = O_IMP + NG * NP, O_VP = O_KP + (size_t)MP * AW, O_RES = O_VP + (size_t)MP * AW, O_IMS = O_RES + (size_t)DB * NG * NP,
                 O_KS = O_IMS + (size_t)DB * NG * NP, O_VS = O_KS + (size_t)MS * AW, O_END = O_VS + (size_t)MS * AW;

constexpr size_t MiB = 1u << 20;
constexpr size_t WS_CTL = 0, CTL_ZERO_BYTES = 1 * MiB;
constexpr size_t WS_SMALL = 1 * MiB;
constexpr size_t SM_ABAR = 0;
constexpr size_t SM_BB = SM_ABAR + 2 * NG * NP * 4;
constexpr size_t SM_LAM = SM_BB + 2 * (size_t)NG * NP * GC * 4;
constexpr size_t SM_END = SM_LAM + 64;
static_assert(SM_END <= 2 * MiB, "small tables");
constexpr size_t WS_SSQ1 = 3 * MiB;
constexpr size_t WS_SSQ2 = 5 * MiB;
constexpr size_t WS_RS0 = 7 * MiB;
constexpr size_t WS_ROPE = 8 * MiB;
constexpr size_t WS_WT1 = 12 * MiB;
constexpr size_t WS_WTG = 28 * MiB;
constexpr size_t WS_WTO = 36 * MiB;
constexpr size_t WS_WT5 = 44 * MiB;
constexpr size_t WS_WTB = 76 * MiB;
constexpr size_t ACT = (size_t)M * DM * 2;
constexpr size_t WS_XB = 84 * MiB;
constexpr size_t WS_UB = WS_XB + 36 * MiB, WS_SZ = WS_UB + 36 * MiB, WS_YG = WS_SZ + 36 * MiB, WS_OB = WS_YG + 36 * MiB,
                 WS_X1B = WS_OB + 36 * MiB, WS_KB = WS_X1B + 36 * MiB, WS_VB = WS_KB + 36 * MiB, WS_QB = WS_VB + 36 * MiB,
                 WS_SZ2 = WS_QB + 36 * MiB, WS_AB = WS_SZ2 + 36 * MiB;
constexpr size_t WS_X1 = WS_AB + 36 * MiB;
constexpr size_t WS_X2 = WS_X1 + 72 * MiB;
constexpr size_t WS_END = WS_X2 + 72 * MiB;
static_assert(ACT <= 36 * MiB, "act");
constexpr int CW_TMO = 0, CW_CODE = 1;
constexpr int CW_BAR = 4096;

typedef unsigned short bf16_t;
typedef short bf16x8 __attribute__((ext_vector_type(8)));
typedef float f32x4 __attribute__((ext_vector_type(4)));
typedef unsigned u32x4 __attribute__((ext_vector_type(4)));
typedef unsigned u32x2 __attribute__((ext_vector_type(2)));

__device__ __forceinline__ unsigned f2bf(float f) { unsigned u = __builtin_bit_cast(unsigned, f); return (u + 0x7fffu + ((u >> 16) & 1u)) >> 16; }
__device__ __forceinline__ unsigned pk2(float lo, float hi) { return f2bf(lo) | (f2bf(hi) << 16); }
__device__ __forceinline__ float bf2f(unsigned short b) { return __builtin_bit_cast(float, (unsigned)b << 16); }
__device__ __forceinline__ float bflo(unsigned w) { return __builtin_bit_cast(float, w << 16); }
__device__ __forceinline__ float bfhi(unsigned w) { return __builtin_bit_cast(float, w & 0xffff0000u); }
__device__ __forceinline__ float wave_sum(float v) {
#pragma unroll
    for (int o = 1; o < 64; o <<= 1) v += __shfl_xor(v, o);
    return v;
}
__device__ __forceinline__ float wave_max(float v) {
#pragma unroll
    for (int o = 1; o < 64; o <<= 1) v = fmaxf(v, __shfl_xor(v, o));
    return v;
}
__device__ __forceinline__ float sigmoid_fast(float z) { return __builtin_amdgcn_rcpf(1.f + __builtin_amdgcn_exp2f(-1.4426950408889634f * z)); }
__device__ __forceinline__ float silu_fast(float z) { return z * sigmoid_fast(z); }
__device__ __forceinline__ float gelu_tanh_f(float x) { const float t = 0.7978845608028654f * (x + 0.044715f * x * x * x); return 0.5f * x * (1.f + tanhf(t)); }
__host__ __device__ __forceinline__ int wt5_row(int n) { const int tile = n >> 8, w = n & 255, blk = w >> 7, i = w & 127; return tile * 256 + (i >> 6) * 128 + blk * 64 + (i & 63); }
namespace pg8 {
#define PG8_LAS __attribute__((address_space(3)))
typedef unsigned short bf16_t;
typedef short bf16x8 __attribute__((ext_vector_type(8)));
typedef float f32x4 __attribute__((ext_vector_type(4)));
typedef unsigned u32x4 __attribute__((ext_vector_type(4)));
constexpr int BM = 256, BK = 64, HALF = 128, HTB = HALF * BK * 2  , STAGE_BYTES = 8 * HTB, NXCD = 8, WGM = 8;

__host__ __device__ __forceinline__ int lds_byte(int r, int c) { const int st = (r >> 4) * 2 + (c >> 5), rr = r & 15, cc = c & 31, ob = rr * 64 + cc * 2; return st * 1024 + (ob ^ (((ob >> 9) & 1) << 5)); }
__host__ __device__ __forceinline__ void stage_rc(int b, int& R, int& C) { const int st = b / 1024, sb = b % 1024, swz = sb ^ (((sb >> 9) & 1) << 5); R = (st >> 1) * 16 + swz / 64; C = (st & 1) * 32 + (swz % 64) / 2; }
__host__ __device__ __forceinline__ int perm32(int rho) { const int n = rho >> 4, i = rho & 15; return 8 * (i >> 2) + 4 * n + (i & 3); }

struct Unit { int pm, pn; };
struct Gemm { const bf16_t* A; const bf16_t* Bt; int M, N, K; };

struct StaticOrder {
    int nM, nN, nwg, G, c;
    __host__ __device__ void init(int M, int N, int G_, int c_) { nM = M / BM; nN = N / BM; nwg = nM * nN; G = G_; c = c_; }
    __host__ __device__ bool next(int i, Unit& u) const {
        const long L = (long)i * G + c; if (L >= nwg) return false;
        int wgid = (int)L; { const int q = nwg / NXCD, r = nwg % NXCD, xcd = wgid % NXCD, off = wgid / NXCD; wgid = (xcd < r ? xcd * (q + 1) : r * (q + 1) + (xcd - r) * q) + off; }
        const int nig = WGM * nN, gid = wgid / nig, fm = gid * WGM, gsz = (nM - fm) < WGM ? (nM - fm) : WGM;
        u.pm = fm + ((wgid % nig) % gsz); u.pn = (wgid % nig) / gsz; return true;
    }
    __device__ __forceinline__ void a_ready(const Unit&) const {}
    __device__ __forceinline__ void done(const Unit&) const {}
};

__device__ __forceinline__ unsigned cvt_pk_bf16(float lo, float hi) { unsigned r; asm volatile("v_cvt_pk_bf16_f32 %0, %1, %2" : "=v"(r) : "v"(lo), "v"(hi)); return r; }
__device__ __forceinline__ float sigm(float z) { return __builtin_amdgcn_rcpf(1.f + __builtin_amdgcn_exp2f(-1.4426950408889634f * z)); }
__device__ __forceinline__ u32x4 pack8(const f32x4& a, const f32x4& b) { u32x4 w; w.x = cvt_pk_bf16(a[0], a[1]); w.y = cvt_pk_bf16(a[2], a[3]); w.z = cvt_pk_bf16(b[0], b[1]); w.w = cvt_pk_bf16(b[2], b[3]); return w; }
__device__ __forceinline__ f32x4 unlo(const u32x4& w) { return (f32x4){__builtin_bit_cast(float, w.x << 16), __builtin_bit_cast(float, w.x & 0xffff0000u), __builtin_bit_cast(float, w.y << 16), __builtin_bit_cast(float, w.y & 0xffff0000u)}; }
__device__ __forceinline__ f32x4 unhi(const u32x4& w) { return (f32x4){__builtin_bit_cast(float, w.z << 16), __builtin_bit_cast(float, w.z & 0xffff0000u), __builtin_bit_cast(float, w.w << 16), __builtin_bit_cast(float, w.w & 0xffff0000u)}; }
__device__ __forceinline__ f32x4 silu4(const f32x4& v) { return (f32x4){v[0] * sigm(v[0]), v[1] * sigm(v[1]), v[2] * sigm(v[2]), v[3] * sigm(v[3])}; }
__device__ __forceinline__ f32x4 sigm4(const f32x4& v) { return (f32x4){sigm(v[0]), sigm(v[1]), sigm(v[2]), sigm(v[3])}; }

struct EpiUZ {
    static constexpr bool PERM = true, AFTER_DRAIN = false;
    bf16_t* Ub; bf16_t* SZ; const float* rs;
    __device__ __forceinline__ void operator()(const f32x4 (&acc)[2][2][4][2], const Unit& u, int wr, int wc, int fr, int fq) const {
        const int row0 = u.pm * BM + wr * 64 + fr; const bool isz = u.pn >= 8; bf16_t* base = isz ? SZ : Ub; const int col0 = (u.pn & 7) * BM + wc * 32 + 8 * fq;
#pragma unroll
        for (int ai = 0; ai < 2; ++ai)
#pragma unroll
            for (int m = 0; m < 4; ++m) { const int row = row0 + ai * HALF + m * 16; const float s = rs[row]; bf16_t* rowp = base + (size_t)row * 2048 + col0;
#pragma unroll
                for (int bj = 0; bj < 2; ++bj) { f32x4 v0 = acc[ai][bj][m][0] * s, v1 = acc[ai][bj][m][1] * s;
                    if (isz) { v0 = silu4(v0); v1 = silu4(v1); }
                    *(u32x4*)(rowp + bj * HALF) = pack8(v0, v1); } }
    }
};
struct EpiGlu {
    static constexpr bool PERM = true, AFTER_DRAIN = false;
    const bf16_t* Yg; const bf16_t* SZ; bf16_t* Ob;
    __device__ __forceinline__ void operator()(const f32x4 (&acc)[2][2][4][2], const Unit& u, int wr, int wc, int fr, int fq) const {
        const int row0 = u.pm * BM + wr * 64 + fr; const int col0 = u.pn * BM + wc * 32 + 8 * fq;
#pragma unroll
        for (int ai = 0; ai < 2; ++ai)
#pragma unroll
            for (int m = 0; m < 4; ++m) { const size_t off = (size_t)(row0 + ai * HALF + m * 16) * 2048 + col0;
#pragma unroll
                for (int bj = 0; bj < 2; ++bj) { const u32x4 y = *(const u32x4*)(Yg + off + bj * HALF), z = *(const u32x4*)(SZ + off + bj * HALF);
                    const f32x4 v0 = unlo(y) * sigm4(acc[ai][bj][m][0]) * unlo(z), v1 = unhi(y) * sigm4(acc[ai][bj][m][1]) * unhi(z);
                    *(u32x4*)(Ob + off + bj * HALF) = pack8(v0, v1); } }
    }
};
struct EpiRes {
    static constexpr bool PERM = true, AFTER_DRAIN = false;
    const float* base_p; const float* base_s; float* X; bf16_t* Xb; float* ssq;
    __device__ __forceinline__ void operator()(const f32x4 (&acc)[2][2][4][2], const Unit& u, int wr, int wc, int fr, int fq) const {
        const int row0 = u.pm * BM + wr * 64 + fr; const int col0 = u.pn * BM + wc * 32 + 8 * fq;
        const bool prm = u.pm < MP / BM; const float* bs = prm ? base_p : base_s; const size_t bsub = prm ? 0 : (size_t)MP * 2048;
#pragma unroll
        for (int ai = 0; ai < 2; ++ai)
#pragma unroll
            for (int m = 0; m < 4; ++m) { const int row = row0 + ai * HALF + m * 16; const size_t off = (size_t)row * 2048 + col0; float q = 0.f;
#pragma unroll
                for (int bj = 0; bj < 2; ++bj) { const f32x4 b0 = *(const f32x4*)(bs + (off - bsub) + bj * HALF), b1 = *(const f32x4*)(bs + (off - bsub) + bj * HALF + 4);
                    const f32x4 v0 = b0 + acc[ai][bj][m][0], v1 = b1 + acc[ai][bj][m][1];
                    *(f32x4*)(X + off + bj * HALF) = v0; *(f32x4*)(X + off + bj * HALF + 4) = v1;
                    q += (v0[0] * v0[0] + v0[1] * v0[1]) + (v0[2] * v0[2] + v0[3] * v0[3]) + (v1[0] * v1[0] + v1[1] * v1[1]) + (v1[2] * v1[2] + v1[3] * v1[3]);
                    if (Xb) *(u32x4*)(Xb + off + bj * HALF) = pack8(v0, v1); }
                q += __shfl_xor(q, 16); q += __shfl_xor(q, 32);
                if (fq == 0) ssq[(size_t)row * NSSQ + u.pn * 4 + wc] = q; }
    }
};
struct EpiKVQZ {
    static constexpr bool PERM = true, AFTER_DRAIN = false;
    const float* ssq; const float* rope; float* out; bf16_t* Kb; bf16_t* Vb; bf16_t* Qb; bf16_t* SZ2;
    __device__ __forceinline__ void operator()(const f32x4 (&acc)[2][2][4][2], const Unit& u, int wr, int wc, int fr, int fq) const {
        const int row0 = u.pm * BM + wr * 64 + fr; const int kind = u.pn >> 3; const int f0 = 32 * (wc & 1) + 8 * fq;
        const int lcol = (u.pn & 7) * BM + (wc >> 1) * 128 + f0;
        const bool prm = u.pm < MP / BM;
        float* ko = prm ? out + O_KP : out + O_KS; float* vo = prm ? out + O_VP : out + O_VS; const size_t osub = prm ? 0 : (size_t)MP * 2048;
#pragma unroll
        for (int ai = 0; ai < 2; ++ai)
#pragma unroll
            for (int m = 0; m < 4; ++m) { const int row = row0 + ai * HALF + m * 16; const size_t off = (size_t)row * 2048 + lcol;
                const f32x4 p0 = *(const f32x4*)(ssq + (size_t)row * NSSQ + 8 * fq), p1 = *(const f32x4*)(ssq + (size_t)row * NSSQ + 8 * fq + 4);
                float q = (p0[0] + p0[1]) + (p0[2] + p0[3]) + (p1[0] + p1[1]) + (p1[2] + p1[3]); q += __shfl_xor(q, 16); q += __shfl_xor(q, 32);
                const float rs = 1.0f / sqrtf(q * (1.0f / 2048.0f) + EPS);
                f32x4 a0 = acc[ai][0][m][0] * rs, a1 = acc[ai][0][m][1] * rs, b0 = acc[ai][1][m][0] * rs, b1 = acc[ai][1][m][1] * rs;
                if (kind == 0 || kind == 2) {
                    const int pos = prm ? row : PAST + ((row - MP) & 15);
                    const float* cp = rope + (size_t)pos * 64 + f0; const float* sp = cp + (size_t)SEQ * 64;
                    const f32x4 c0 = *(const f32x4*)cp, c1 = *(const f32x4*)(cp + 4), s0 = *(const f32x4*)sp, s1 = *(const f32x4*)(sp + 4);
                    const f32x4 y0 = a0 * c0 - b0 * s0, y1 = a1 * c1 - b1 * s1, z0 = a0 * s0 + b0 * c0, z1 = a1 * s1 + b1 * c1;
                    a0 = y0; a1 = y1; b0 = z0; b1 = z1;
                }
                if (kind == 0) { { float* o = ko + (off - osub); *(f32x4*)(o) = a0; *(f32x4*)(o + 4) = a1; *(f32x4*)(o + 64) = b0; *(f32x4*)(o + 68) = b1; }
                    *(u32x4*)(Kb + off) = pack8(a0, a1); *(u32x4*)(Kb + off + 64) = pack8(b0, b1); }
                else if (kind == 1) { { float* o = vo + (off - osub); *(f32x4*)(o) = a0; *(f32x4*)(o + 4) = a1; *(f32x4*)(o + 64) = b0; *(f32x4*)(o + 68) = b1; }
                    *(u32x4*)(Vb + off) = pack8(a0, a1); *(u32x4*)(Vb + off + 64) = pack8(b0, b1); }
                else if (kind == 2) { *(u32x4*)(Qb + off) = pack8(a0 * QSCALE, a1 * QSCALE); *(u32x4*)(Qb + off + 64) = pack8(b0 * QSCALE, b1 * QSCALE); }
                else { *(u32x4*)(SZ2 + off) = pack8(silu4(a0), silu4(a1)); *(u32x4*)(SZ2 + off + 64) = pack8(silu4(b0), silu4(b1)); } }
    }
};
template <class Epi, class Sched, bool ALIGN_EPI = false, bool SP2 = false>
__device__ __forceinline__ void gemm_phase(PG8_LAS unsigned char* lds, const Gemm g, const Sched& S, const Epi& E) {
    const int tid = threadIdx.x, wid = __builtin_amdgcn_readfirstlane(tid >> 6), lane = tid & 63, wr = wid >> 2, wc = wid & 3, fr = lane & 15, fq = lane >> 4;
    const int K = g.K, nt = K / BK;
    unsigned voffA[2], voffB[2];
#pragma unroll
    for (int i = 0; i < 2; ++i) { int R, C; stage_rc(tid * 16 + i * 8192, R, C); const int Rb = Epi::PERM ? ((R & ~31) + perm32(R & 31)) : R;
        voffA[i] = (unsigned)(R * K + C) * 2u; voffB[i] = (unsigned)(Rb * K + C) * 2u; }
    const size_t kstep = (size_t)(BK * 2);
    const size_t hstep = (size_t)HALF * K * 2;
    const size_t tstep = 2 * hstep;
    const unsigned ldsw = (unsigned)wid * 1024u;
    const int aoff = lds_byte(wr * 64 + fr, fq * 8), boff = lds_byte(wc * 32 + fr, fq * 8);
#define PG8_SA(b, h) (((b) * 2 + (h)) * HTB)
#define PG8_SB(b, h) ((4 + (b) * 2 + (h)) * HTB)
#define PG8_STAGE(bufoff, gbase, voff) do { _Pragma("unroll") for (int _i = 0; _i < 2; ++_i) \
        __builtin_amdgcn_global_load_lds((const unsigned*)((const char*)(gbase) + (voff)[_i]), (PG8_LAS unsigned*)(lds + (bufoff) + ldsw + _i * 8192), 16, 0, 0); } while (0)
#define PG8_LDA(dst, b, h) do { _Pragma("unroll") for (int m = 0; m < 4; ++m) _Pragma("unroll") for (int k = 0; k < 2; ++k) dst[m][k] = *(const PG8_LAS bf16x8*)(lds + PG8_SA(b, h) + aoff + m * 2048 + k * 1024); } while (0)
#define PG8_LDB(dst, b, h) do { _Pragma("unroll") for (int n = 0; n < 2; ++n) _Pragma("unroll") for (int k = 0; k < 2; ++k) dst[n][k] = *(const PG8_LAS bf16x8*)(lds + PG8_SB(b, h) + boff + n * 2048 + k * 1024); } while (0)
#define PG8_MMA(ai, bj, At, Bt) do { __builtin_amdgcn_s_setprio(1); _Pragma("unroll") for (int m = 0; m < 4; ++m) _Pragma("unroll") for (int n = 0; n < 2; ++n) _Pragma("unroll") for (int k = 0; k < 2; ++k) \
        acc[ai][bj][m][n] = __builtin_amdgcn_mfma_f32_16x16x32_bf16(Bt[n][k], At[m][k], acc[ai][bj][m][n], 0, 0, 0); __builtin_amdgcn_s_setprio(0); } while (0)
#define PG8_WAIT_V(n) asm volatile("s_waitcnt vmcnt(" #n ")" ::: "memory")
#define PG8_WAIT_L(n) asm volatile("s_waitcnt lgkmcnt(" #n ")" ::: "memory")
#define PG8_BAR __builtin_amdgcn_s_barrier()
#define PG8_SCHED __builtin_amdgcn_sched_barrier(0)
    Unit cur, nxt; int ui = 0;
    if (!S.next(0, cur)) return;
    f32x4 acc[2][2][4][2];
#pragma unroll
    for (int a = 0; a < 2; ++a)
#pragma unroll
        for (int b = 0; b < 2; ++b)
#pragma unroll
            for (int m = 0; m < 4; ++m)
#pragma unroll
                for (int n = 0; n < 2; ++n) acc[a][b][m][n] = (f32x4){0.f, 0.f, 0.f, 0.f};
    bf16x8 At[4][2], B0[2][2], B1[2][2];
    const char* cA = (const char*)g.A + (size_t)cur.pm * tstep; const char* cB = (const char*)g.Bt + (size_t)cur.pn * tstep;
    S.a_ready(cur);
    if constexpr (SP2) {
        PG8_STAGE(PG8_SB(0, 0), cB, voffB); PG8_STAGE(PG8_SB(0, 1), cB + hstep, voffB); PG8_STAGE(PG8_SA(0, 0), cA, voffA); PG8_STAGE(PG8_SA(0, 1), cA + hstep, voffA);
        if (wr == 1) PG8_BAR;
        PG8_WAIT_V(2); PG8_BAR;
        PG8_STAGE(PG8_SB(1, 0), cB + kstep, voffB); PG8_STAGE(PG8_SA(1, 0), cA + kstep, voffA); PG8_STAGE(PG8_SB(1, 1), cB + hstep + kstep, voffB);
        PG8_WAIT_V(6); PG8_BAR;
    } else {
        PG8_STAGE(PG8_SB(0, 0), cB, voffB); PG8_STAGE(PG8_SA(0, 0), cA, voffA); PG8_STAGE(PG8_SB(0, 1), cB + hstep, voffB); PG8_STAGE(PG8_SA(0, 1), cA + hstep, voffA);
        if (wr == 1) PG8_BAR;
        PG8_WAIT_V(4); PG8_BAR;
        PG8_STAGE(PG8_SB(1, 0), cB + kstep, voffB); PG8_STAGE(PG8_SA(1, 0), cA + kstep, voffA); PG8_STAGE(PG8_SB(1, 1), cB + hstep + kstep, voffB);
        PG8_WAIT_V(6); PG8_BAR;
    }
    for (;;) {
        const bool has_next = S.next(ui + 1, nxt);
        const char* nA = has_next ? (const char*)g.A + (size_t)nxt.pm * tstep : cA; const char* nB = has_next ? (const char*)g.Bt + (size_t)nxt.pn * tstep : cB;
        for (int t = 0; t < nt; t += 2) {
            const bool last = (t == nt - 2);
            const char* a1 = cA + (size_t)(t + 1) * kstep;
            const char* a2 = last ? nA : cA + (size_t)(t + 2) * kstep; const char* b2 = last ? nB : cB + (size_t)(t + 2) * kstep;
            const char* a3 = a2 + kstep; const char* b3 = b2 + kstep;
            if (last && has_next) S.a_ready(nxt);
            if constexpr (SP2) {
            PG8_LDB(B0, 0, 0); PG8_LDB(B1, 0, 1); PG8_SCHED; PG8_LDA(At, 0, 0); PG8_STAGE(PG8_SA(1, 1), a1 + hstep, voffA);
            PG8_WAIT_V(8); PG8_WAIT_L(0); PG8_BAR; PG8_MMA(0, 0, At, B0); PG8_MMA(0, 1, At, B1); PG8_BAR; PG8_SCHED;
            PG8_LDA(At, 0, 1); PG8_STAGE(PG8_SB(0, 0), b2, voffB); PG8_STAGE(PG8_SB(0, 1), b2 + hstep, voffB); PG8_STAGE(PG8_SA(0, 0), a2, voffA);
            PG8_WAIT_V(8); PG8_WAIT_L(0); PG8_BAR; PG8_MMA(1, 0, At, B0); PG8_MMA(1, 1, At, B1); PG8_BAR; PG8_SCHED;
            PG8_LDB(B0, 1, 0); PG8_LDB(B1, 1, 1); PG8_SCHED; PG8_LDA(At, 1, 0); PG8_STAGE(PG8_SA(0, 1), a2 + hstep, voffA);
            PG8_WAIT_V(8); PG8_WAIT_L(0); PG8_BAR; PG8_MMA(0, 0, At, B0); PG8_MMA(0, 1, At, B1); PG8_BAR; PG8_SCHED;
            PG8_LDA(At, 1, 1); PG8_STAGE(PG8_SB(1, 0), b3, voffB); PG8_STAGE(PG8_SB(1, 1), b3 + hstep, voffB); PG8_STAGE(PG8_SA(1, 0), a3, voffA);
            PG8_WAIT_V(8); PG8_WAIT_L(0); PG8_BAR; PG8_MMA(1, 0, At, B0); PG8_MMA(1, 1, At, B1); PG8_BAR; PG8_SCHED;
            } else {
            PG8_LDB(B0, 0, 0); PG8_SCHED; PG8_LDA(At, 0, 0); PG8_STAGE(PG8_SA(1, 1), a1 + hstep, voffA);
            PG8_WAIT_L(8); PG8_BAR; PG8_WAIT_L(0); PG8_MMA(0, 0, At, B0); PG8_BAR; PG8_SCHED;
            PG8_LDB(B1, 0, 1); PG8_STAGE(PG8_SB(0, 0), b2, voffB);
            PG8_BAR; PG8_WAIT_L(0); PG8_MMA(0, 1, At, B1); PG8_BAR;
            PG8_LDA(At, 0, 1); PG8_STAGE(PG8_SA(0, 0), a2, voffA);
            PG8_BAR; PG8_WAIT_L(0); PG8_MMA(1, 0, At, B0); PG8_BAR; PG8_SCHED;
            PG8_STAGE(PG8_SB(0, 1), b2 + hstep, voffB);
            PG8_WAIT_V(6); PG8_BAR; PG8_MMA(1, 1, At, B1); PG8_BAR;
            PG8_LDB(B0, 1, 0); PG8_SCHED; PG8_LDA(At, 1, 0); PG8_STAGE(PG8_SA(0, 1), a2 + hstep, voffA);
            PG8_WAIT_L(8); PG8_BAR; PG8_WAIT_L(0); PG8_MMA(0, 0, At, B0); PG8_BAR; PG8_SCHED;
            PG8_LDB(B1, 1, 1); PG8_STAGE(PG8_SB(1, 0), b3, voffB);
            PG8_BAR; PG8_WAIT_L(0); PG8_MMA(0, 1, At, B1); PG8_BAR;
            PG8_LDA(At, 1, 1); PG8_STAGE(PG8_SA(1, 0), a3, voffA);
            PG8_BAR; PG8_WAIT_L(0); PG8_MMA(1, 0, At, B0); PG8_BAR; PG8_SCHED;
            PG8_STAGE(PG8_SB(1, 1), b3 + hstep, voffB);
            PG8_WAIT_V(6); PG8_BAR; PG8_MMA(1, 1, At, B1); PG8_BAR;
            }
        }
        if constexpr (ALIGN_EPI) { if (wr == 0) PG8_BAR; }
        if constexpr (!Epi::AFTER_DRAIN) { E(acc, cur, wr, wc, fr, fq); S.done(cur); }
        if (!has_next) break;
#pragma unroll
        for (int a = 0; a < 2; ++a)
#pragma unroll
            for (int b = 0; b < 2; ++b)
#pragma unroll
                for (int m = 0; m < 4; ++m)
#pragma unroll
                    for (int n = 0; n < 2; ++n) acc[a][b][m][n] = (f32x4){0.f, 0.f, 0.f, 0.f};
        cur = nxt; cA = nA; cB = nB; ++ui;
        if constexpr (ALIGN_EPI) { if (wr == 1) PG8_BAR; }
    }
    PG8_WAIT_V(0);
    if constexpr (!ALIGN_EPI) { if (wr == 0) PG8_BAR; }
    PG8_BAR;
    if constexpr (Epi::AFTER_DRAIN) { E.fused(acc, cur, wr, wc, fr, fq, lds, wid, lane); S.done(cur); }
#undef PG8_SA
#undef PG8_SB
#undef PG8_STAGE
#undef PG8_LDA
#undef PG8_LDB
#undef PG8_MMA
#undef PG8_WAIT_V
#undef PG8_WAIT_L
#undef PG8_BAR
#undef PG8_SCHED
}
}

namespace sk {
using pg8::bf16_t; using pg8::bf16x8; using pg8::f32x4; using pg8::u32x4;
typedef unsigned u32x2 __attribute__((ext_vector_type(2)));
__device__ __forceinline__ u32x2 pack4(const f32x4& a) { u32x2 w; w.x = pg8::cvt_pk_bf16(a[0], a[1]); w.y = pg8::cvt_pk_bf16(a[2], a[3]); return w; }
__device__ __forceinline__ f32x4 un4(const u32x2& w) { return (f32x4){__builtin_bit_cast(float, w.x << 16), __builtin_bit_cast(float, w.x & 0xffff0000u), __builtin_bit_cast(float, w.y << 16), __builtin_bit_cast(float, w.y & 0xffff0000u)}; }
struct EpiUZ { bf16_t* Ub; bf16_t* SZ; const float* rs;
    __device__ __forceinline__ void operator()(int row, int ct, int w, int fq, f32x4 v0, f32x4 v1) const {
        const float s = rs[row]; const bool isz = ct >= 8; bf16_t* p = (isz ? SZ : Ub) + (size_t)row * 2048 + (ct & 7) * 256 + 16 * w + 4 * fq;
        v0 = v0 * s; v1 = v1 * s; if (isz) { v0 = pg8::silu4(v0); v1 = pg8::silu4(v1); }
        *(u32x2*)p = pack4(v0); *(u32x2*)(p + 128) = pack4(v1); } };
struct EpiGlu { const bf16_t* Yg; const bf16_t* SZ; bf16_t* Ob;
    __device__ __forceinline__ void operator()(int row, int ct, int w, int fq, f32x4 v0, f32x4 v1) const {
        const size_t off = (size_t)row * 2048 + ct * 256 + 16 * w + 4 * fq;
        const u32x2 y0 = *(const u32x2*)(Yg + off), y1 = *(const u32x2*)(Yg + off + 128), z0 = *(const u32x2*)(SZ + off), z1 = *(const u32x2*)(SZ + off + 128);
        *(u32x2*)(Ob + off) = pack4(un4(y0) * pg8::sigm4(v0) * un4(z0)); *(u32x2*)(Ob + off + 128) = pack4(un4(y1) * pg8::sigm4(v1) * un4(z1)); } };
struct EpiRes { const float* base; float* X; bf16_t* Xb; float* ssq;
    __device__ __forceinline__ void operator()(int row, int ct, int w, int fq, f32x4 v0, f32x4 v1) const {
        const size_t off = (size_t)row * 2048 + ct * 256 + 16 * w + 4 * fq;
        v0 += *(const f32x4*)(base + off); v1 += *(const f32x4*)(base + off + 128);
        *(f32x4*)(X + off) = v0; *(f32x4*)(X + off + 128) = v1;
        if (Xb) { *(u32x2*)(Xb + off) = pack4(v0); *(u32x2*)(Xb + off + 128) = pack4(v1); }
        float q = (v0[0] * v0[0] + v0[1] * v0[1]) + (v0[2] * v0[2] + v0[3] * v0[3]) + (v1[0] * v1[0] + v1[1] * v1[1]) + (v1[2] * v1[2] + v1[3] * v1[3]);
        q += __shfl_xor(q, 16); q += __shfl_xor(q, 32);
        if (fq == 0) atomicAdd(ssq + (size_t)row * NSSQ + ct * 4 + (w >> 1), q); } };
struct EpiKVQZ { const float* ssq; const float* rope; float* out; bf16_t* Kb; bf16_t* Vb; bf16_t* Qb; bf16_t* SZ2;
    __device__ __forceinline__ void operator()(int row, int ct, int w, int fq, f32x4 a, f32x4 b) const {
        const int kind = ct >> 3, f0 = 16 * (w & 3) + 4 * fq; const size_t off = (size_t)row * 2048 + (ct & 7) * 256 + (w >> 2) * 128 + f0;
        const f32x4 p0 = *(const f32x4*)(ssq + (size_t)row * NSSQ + 8 * fq), p1 = *(const f32x4*)(ssq + (size_t)row * NSSQ + 8 * fq + 4);
        float q = (p0[0] + p0[1]) + (p0[2] + p0[3]) + (p1[0] + p1[1]) + (p1[2] + p1[3]); q += __shfl_xor(q, 16); q += __shfl_xor(q, 32);
        const float rs = 1.0f / sqrtf(q * (1.0f / 2048.0f) + EPS);
        a = a * rs; b = b * rs;
        if (kind == 0 || kind == 2) { const int pos = PAST + ((row - MP) & 15); const float* cp = rope + (size_t)pos * 64 + f0;
            const f32x4 c = *(const f32x4*)cp, s = *(const f32x4*)(cp + (size_t)SEQ * 64); const f32x4 y = a * c - b * s, z = a * s + b * c; a = y; b = z; }
        const size_t oo = off - (size_t)MP * 2048;
        if (kind == 0) { *(f32x4*)(out + O_KS + oo) = a; *(f32x4*)(out + O_KS + oo + 64) = b; *(u32x2*)(Kb + off) = pack4(a); *(u32x2*)(Kb + off + 64) = pack4(b); }
        else if (kind == 1) { *(f32x4*)(out + O_VS + oo) = a; *(f32x4*)(out + O_VS + oo + 64) = b; *(u32x2*)(Vb + off) = pack4(a); *(u32x2*)(Vb + off + 64) = pack4(b); }
        else if (kind == 2) { *(u32x2*)(Qb + off) = pack4(a * QSCALE); *(u32x2*)(Qb + off + 64) = pack4(b * QSCALE); }
        else { *(u32x2*)(SZ2 + off) = pack4(pg8::silu4(a)); *(u32x2*)(SZ2 + off + 64) = pack4(pg8::silu4(b)); } } };
template <int N_> __device__ __forceinline__ void sk_wait() {
#define SK_W(n) else if constexpr (N_ == n) asm volatile("s_waitcnt vmcnt(" #n ")" ::: "memory");
    if constexpr (N_ == 0) asm volatile("s_waitcnt vmcnt(0)" ::: "memory");
    SK_W(2) SK_W(3) SK_W(4) SK_W(6) SK_W(8)
    else static_assert(N_ == 0, "sk_wait: add the count");
#undef SK_W
}
template <int RBK, int CW, class Epi> __device__ __forceinline__ void phase(PG8_LAS unsigned char* lds, const bf16_t* A, const bf16_t* Bt, int N, const Epi& E, int vcu, int nwg) {
    constexpr int K = 2048, NT = K / 64, NCB = CW / 16, RBW = RBK * NCB / 8, NCQ = 128 / CW, NRG = DB / RBK;
    constexpr int NBP = 2 * CW / 8, NAP = 16 * RBK / 8, P = (NBP + NAP) / 8, A_OFF = NBP * 1024, SLOT = (NBP + NAP) * 1024, NS = 4;
    static_assert((NBP + NAP) % 8 == 0 && RBW >= 1 && NS * SLOT <= 131072, "skinny item shape");
    const int tid = threadIdx.x, w = __builtin_amdgcn_readfirstlane(tid >> 6), lane = tid & 63, fr = lane & 15, fq = lane >> 4;
    const int nitems = NRG * (N / 256) * NCQ, cbp = w % NCB, rsub = w / NCB;
    const int rd0 = fr * 128 + ((fq ^ (fr & 7)) * 16), rd1 = fr * 128 + (((4 + fq) ^ (fr & 7)) * 16);
    for (int it = vcu; it < nitems; it += nwg) {
        const int rg = it % NRG, ccol = it / NRG, ct = ccol / NCQ, cq = ccol % NCQ, r0 = MP + 16 * RBK * rg;
        const char* src[P]; unsigned dst[P];
#pragma unroll
        for (int j = 0; j < P; ++j) { const int gp = w * P + j; const bool isb = gp < NBP; const int p = isb ? gp : gp - NBP, row = 8 * p + (lane >> 3), cl = (lane & 7) ^ (row & 7);
            const size_t grow = isb ? (size_t)(ct * 256 + (row < CW ? cq * CW + row : 128 + cq * CW + (row - CW))) : (size_t)(r0 + row);
            src[j] = (const char*)((isb ? Bt : A) + grow * K) + cl * 16; dst[j] = (unsigned)((isb ? 0 : A_OFF) + p * 1024); }
#define SK_STAGE(s, t) do { _Pragma("unroll") for (int j_ = 0; j_ < P; ++j_) \
            __builtin_amdgcn_global_load_lds((const unsigned*)(src[j_] + (size_t)(t) * 128), (PG8_LAS unsigned*)(lds + (s) * SLOT + __builtin_amdgcn_readfirstlane((int)dst[j_])), 16, 0, 0); } while (0)
        f32x4 acc[RBW][2];
#pragma unroll
        for (int i = 0; i < RBW; ++i) { acc[i][0] = (f32x4){0.f, 0.f, 0.f, 0.f}; acc[i][1] = (f32x4){0.f, 0.f, 0.f, 0.f}; }
        SK_STAGE(0, 0); SK_STAGE(1, 1); SK_STAGE(2, 2);
        for (int t4 = 0; t4 < NT / 4; ++t4) {
#define SK_STEP(u) do { const int t = 4 * t4 + (u); \
            if (t + 2 < NT) sk_wait<2 * P>(); else if (t + 1 < NT) sk_wait<P>(); else sk_wait<0>();       \
            asm volatile("s_waitcnt lgkmcnt(0)" ::: "memory"); __builtin_amdgcn_s_barrier(); asm volatile("" ::: "memory"); \
            if (t + 3 < NT) SK_STAGE(((u) + 3) & 3, t + 3);                                              \
            bf16x8 af[RBW][2]; \
            _Pragma("unroll") for (int i_ = 0; i_ < RBW; ++i_) { const int ab_ = (u) * SLOT + A_OFF + (rsub * RBW + i_) * 2048; af[i_][0] = *(const PG8_LAS bf16x8*)(lds + ab_ + rd0); af[i_][1] = *(const PG8_LAS bf16x8*)(lds + ab_ + rd1); } \
            _Pragma("unroll") for (int h_ = 0; h_ < 2; ++h_) { const int bb_ = (u) * SLOT + (h_ * CW + 16 * cbp) * 128; \
                const bf16x8 b0_ = *(const PG8_LAS bf16x8*)(lds + bb_ + rd0), b1_ = *(const PG8_LAS bf16x8*)(lds + bb_ + rd1); \
                _Pragma("unroll") for (int i_ = 0; i_ < RBW; ++i_) { acc[i_][h_] = __builtin_amdgcn_mfma_f32_16x16x32_bf16(b0_, af[i_][0], acc[i_][h_], 0, 0, 0); \
                    acc[i_][h_] = __builtin_amdgcn_mfma_f32_16x16x32_bf16(b1_, af[i_][1], acc[i_][h_], 0, 0, 0); } } } while (0)
            SK_STEP(0); SK_STEP(1); SK_STEP(2); SK_STEP(3);
#undef SK_STEP
        }
        asm volatile("s_waitcnt vmcnt(0) lgkmcnt(0)" ::: "memory"); __builtin_amdgcn_s_barrier(); asm volatile("" ::: "memory");
#pragma unroll
        for (int i = 0; i < RBW; ++i) E(r0 + 16 * (rsub * RBW + i) + fr, ct, cq * NCB + cbp, fq, acc[i][0], acc[i][1]);
#undef SK_STAGE
    }
}
}

constexpr int NWAVES = 8;
constexpr int RING_OFF = 0, RING_BYTES = 131072;
constexpr int LDSCTL_OFF = RING_BYTES, MISC_OFF = LDSCTL_OFF + 320;
constexpr int LDS_BYTES = 155648;
static_assert(MISC_OFF + 128 <= LDS_BYTES, "LDS map");

#define GAS __attribute__((address_space(1)))
#define LAS __attribute__((address_space(3)))
typedef GAS unsigned gu32;
#define RLX_AGENT __ATOMIC_RELAXED, __HIP_MEMORY_SCOPE_AGENT
#define LDS_WAIT() asm volatile("s_waitcnt lgkmcnt(0)" ::: "memory")
#define VM_WAIT() asm volatile("s_waitcnt vmcnt(0)" ::: "memory")
#define XB_TMO      128
#define XB_XCNT(j)  (256  + 64 * (j))
#define XB_XSUB(j)  (1280 + 64 * (j))
#define XB_XGEN(j)  (2304 + 64 * (j))
#define XB_TOP      3328
#define XB_TOPGEN   3392
#define XCD_BAR_WORDS 3456
#define XB_SPIN_CAP (1u << 18)

__device__ __forceinline__ unsigned xb_ld(unsigned* p)              { return __hip_atomic_load(p, __ATOMIC_RELAXED, __HIP_MEMORY_SCOPE_AGENT); }
__device__ __forceinline__ unsigned xb_add(unsigned* p, unsigned v) { return __hip_atomic_fetch_add(p, v, __ATOMIC_RELAXED, __HIP_MEMORY_SCOPE_AGENT); }
__device__ __forceinline__ unsigned xb_xcc_id() { return (unsigned)__builtin_amdgcn_s_getreg((3 << 11) | 20) & 0xFu; }
#define XB_SPIN(cond, bar) do { unsigned _sp = 0; while (cond) { __builtin_amdgcn_s_sleep(1); \
    if ((++_sp & 255u) == 0u) { if (xb_ld(&(bar)[XB_TMO])) break; if (_sp > XB_SPIN_CAP) { atomicAdd(&(bar)[XB_TMO], 1u); break; } } } } while (0)

struct XcdBarrier {
    unsigned* bar; unsigned x;
    volatile LAS unsigned* st;
};

__device__ __forceinline__ XcdBarrier xcd_barrier_post(unsigned* bar, volatile LAS unsigned* st) {
    XcdBarrier b; b.bar = bar; b.x = xb_xcc_id(); b.st = st;
    if (threadIdx.x == 0) (void)xb_add(&bar[XB_XCNT(b.x)], 1u);
    return b;
}
__device__ __forceinline__ void xcd_barrier_complete(unsigned* bar, unsigned x, unsigned& nloc, unsigned& nx) {
    const unsigned G = gridDim.x * gridDim.y * gridDim.z;
    unsigned sum, cnt, mine, sp = 0u;
    for (;;) {
        sum = 0u; cnt = 0u; mine = 0u;
#pragma unroll
        for (unsigned j = 0; j < 16; ++j) { const unsigned c = xb_ld(&bar[XB_XCNT(j)]); sum += c; cnt += (c > 0u) ? 1u : 0u; mine = (j == x) ? c : mine; }
        if (sum == G) break;
        __builtin_amdgcn_s_sleep(1);
        if ((++sp & 255u) == 0u) { if (xb_ld(&bar[XB_TMO])) break; if (sp > XB_SPIN_CAP) { atomicAdd(&bar[XB_TMO], 1u); break; } }
    }
    nloc = mine > 0u ? mine : 1u; nx = cnt > 0u ? cnt : 1u;
}

__device__ __forceinline__ void xcd_barrier(const XcdBarrier& b) {
    asm volatile("s_waitcnt vmcnt(0)" ::: "memory");
    __syncthreads();
    if (threadIdx.x == 0) {
        unsigned* bar = b.bar;
        __builtin_amdgcn_s_waitcnt(0);
        unsigned nloc = b.st[0], nx = b.st[1];
        if (nloc == 0u) { xcd_barrier_complete(bar, b.x, nloc, nx); b.st[0] = nloc; b.st[1] = nx; }
        const unsigned old = xb_add(&bar[XB_XSUB(b.x)], 1u);
        const unsigned gen = old / nloc;
        if (old + 1u == (gen + 1u) * nloc) {
            __builtin_amdgcn_fence(__ATOMIC_RELEASE, "agent");
            asm volatile("s_waitcnt vmcnt(0)" ::: "memory");
            const unsigned og = xb_add(&bar[XB_TOP], 1u);
            const unsigned tg = og / nx;
            if (og + 1u == (tg + 1u) * nx) xb_add(&bar[XB_TOPGEN], 1u);
            else XB_SPIN(xb_ld(&bar[XB_TOPGEN]) == tg, bar);
            __builtin_amdgcn_fence(__ATOMIC_ACQUIRE, "agent");
            xb_add(&bar[XB_XGEN(b.x)], 1u);
            asm volatile("s_waitcnt vmcnt(0)" ::: "memory");
        } else {
            XB_SPIN(xb_ld(&bar[XB_XGEN(b.x)]) == gen, bar);
            __builtin_amdgcn_fence(__ATOMIC_ACQUIRE, "agent");
            asm volatile("s_waitcnt vmcnt(0)" ::: "memory");
        }
    }
    __syncthreads();
}

struct Frame {
    LAS unsigned char* lds;
    volatile LAS unsigned* MISC;
    gu32* ctl;
    int tid, lane, wave;
    int vcu, G;
};
struct Args { const float* in[29]; float* out; unsigned char* ws; int ph_lo, ph_hi, li, pad; };


constexpr size_t WS_MF = 768 * MiB;
constexpr size_t WS_EG = 800 * MiB;
constexpr size_t WS_A16 = 2 * MiB;
constexpr size_t WS_END2 = 816 * MiB;
static_assert(WS_END <= WS_MF, "ws map");

__device__ __forceinline__ void p0_ssm_item(const Args& a, int g, int t, LAS float* scr, int lane) {
    unsigned char* ws = a.ws;
    bf16_t* MFg = (bf16_t*)(ws + WS_MF) + (size_t)g * 256 * 384; bf16_t* Eg = (bf16_t*)(ws + WS_EG) + (size_t)g * 128 * 256; float* A16 = (float*)(ws + WS_A16) + (size_t)g * 128;
    const int p = lane, gp = g * NP + p;
    const double lr = a.in[8][gp], li = a.in[9][gp], dt = exp((double)a.in[10][g]);
    const double zr = lr * dt, zi = li * dt, mag = exp(zr), ar = mag * cos(zi), ai = mag * sin(zi);
    const double nr = ar - 1.0, ni = ai, den = lr * lr + li * li;
    const double cfr = (nr * lr + ni * li) / den, cfi = (ni * lr - nr * li) / den;
    double pr = 1.0, pi = 0.0;
    for (int k = 0; k < t; ++k) { const double x = pr * ar - pi * ai, y = pr * ai + pi * ar; pr = x; pi = y; }
    const double qr = pr * ar - pi * ai, qi = pr * ai + pi * ar;
    u32x4 er[2], ei[2];
#pragma unroll
    for (int c2 = 0; c2 < 8; ++c2) { float wr[2], wi[2];
#pragma unroll
        for (int e = 0; e < 2; ++e) { const int c = 2 * c2 + e; const double br = a.in[11][(size_t)gp * GC + c], bi = a.in[12][(size_t)gp * GC + c];
            const double bbr = cfr * br - cfi * bi, bbi = cfr * bi + cfi * br;
            wr[e] = (float)(pr * bbr - pi * bbi); wi[e] = (float)(pr * bbi + pi * bbr);
            scr[p * 16 + c] = wr[e]; scr[1024 + p * 16 + c] = wi[e]; }
        er[c2 >> 2][c2 & 3] = pk2(wr[0], wr[1]); ei[c2 >> 2][c2 & 3] = pk2(wi[0], wi[1]); }
    { const int j = 15 - t; bf16_t* e0 = Eg + (size_t)p * 256 + 16 * j; bf16_t* e1 = Eg + (size_t)(64 + p) * 256 + 16 * j;
      *(u32x4*)e0 = er[0]; *(u32x4*)(e0 + 8) = er[1]; *(u32x4*)e1 = ei[0]; *(u32x4*)(e1 + 8) = ei[1]; }
    const float fqr = (float)qr, fqi = (float)qi;
#pragma unroll
    for (int c = 0; c < GC; ++c) { const float cr = a.in[13][((size_t)g * GC + c) * NP + p], ci = a.in[14][((size_t)g * GC + c) * NP + p];
        scr[2048 + c * 64 + p] = cr; scr[3072 + c * 64 + p] = ci;
        bf16_t* fr_ = MFg + (size_t)(16 * t + c) * 384 + 256 + p;
        fr_[0] = (bf16_t)f2bf(cr * fqr - ci * fqi); fr_[64] = (bf16_t)f2bf(-(cr * fqi + ci * fqr)); }
    if (t == 15) { A16[p] = fqr; A16[64 + p] = fqi; }
    LDS_WAIT(); asm volatile("" ::: "memory");
    const int c = lane >> 2, c0 = (lane & 3) * 4; f32x4 acc = (f32x4){0.f, 0.f, 0.f, 0.f};
    for (int q = 0; q < NP; ++q) { const float cr = scr[2048 + c * 64 + q], ci = scr[3072 + c * 64 + q];
        const f32x4 wr = *(const LAS f32x4*)(scr + q * 16 + c0), wi = *(const LAS f32x4*)(scr + 1024 + q * 16 + c0);
        acc += wr * cr - wi * ci; }
    u32x2 kv; kv.x = pk2(acc[0], acc[1]); kv.y = pk2(acc[2], acc[3]);
    for (int i = t; i < 16; ++i) *(u32x2*)(MFg + (size_t)(16 * i + c) * 384 + 16 * (i - t) + c0) = kv;
    if (t >= 1) for (int i = 0; i + t < 16; ++i) *(u32x2*)(MFg + (size_t)(16 * i + c) * 384 + 16 * (i + t) + c0) = (u32x2){0u, 0u};
    LDS_WAIT(); asm volatile("" ::: "memory");
}

constexpr int SSM_UST = 264, SSM_HST = 136;
constexpr int SSM_U_OFF = 0, SSM_H_OFF = SSM_U_OFF + 32 * SSM_UST * 2, SSM_S_OFF = SSM_H_OFF + 32 * SSM_HST * 2, SSM_LDS_END = SSM_S_OFF + 128 * 33 * 4;
static_assert(SSM_LDS_END <= RING_BYTES, "ssm lds");
__device__ __forceinline__ float gelu_fast(float x) { const float t = 1.5957691216057308f * (x + 0.044715f * x * x * x); return x * __builtin_amdgcn_rcpf(1.f + __builtin_amdgcn_exp2f(-1.4426950408889634f * t)); }

__device__ __forceinline__ void p2_ssm(Frame& F, const Args& a) {
    unsigned char* ws = a.ws;
    for (int item = F.vcu; item < 2 * NG; item += F.G) {
    const int g = item >> 1, hf = item & 1;
    const bf16_t* MFg = (const bf16_t*)(ws + WS_MF) + (size_t)g * 256 * 384; const bf16_t* Eg = (const bf16_t*)(ws + WS_EG) + (size_t)g * 128 * 256; const float* A16 = (const float*)(ws + WS_A16) + (size_t)g * 128;
    const bf16_t* Ub = (const bf16_t*)(ws + WS_UB); bf16_t* Yg = (bf16_t*)(ws + WS_YG);
    const int w = F.wave, lane = F.lane, fr = lane & 15, fq = lane >> 4, tid = F.tid;
    const int iw = w < 4 ? w : 11 - w, ti = 2 * iw + hf;
    LAS bf16_t* Ul = (LAS bf16_t*)(F.lds + SSM_U_OFF); LAS bf16_t* Hl = (LAS bf16_t*)(F.lds + SSM_H_OFF); LAS float* Sl = (LAS float*)(F.lds + SSM_S_OFF);
    bf16x8 mf[12], ef[8];
#pragma unroll
    for (int ks = 0; ks < 12; ++ks) mf[ks] = *(const bf16x8*)(MFg + (size_t)(16 * ti + fr) * 384 + 32 * ks + 8 * fq);
#pragma unroll
    for (int ks = 0; ks < 8; ++ks) ef[ks] = *(const bf16x8*)(Eg + (size_t)(16 * w + fr) * 256 + 32 * ks + 8 * fq);
    float a16r = 0.f, a16i = 0.f, hr = 0.f, hi = 0.f;
    if (w == 0) { a16r = A16[lane]; a16i = A16[64 + lane]; }
    f32x4 dsk = *(const f32x4*)(a.in[15] + g * GC + 4 * fq);
    u32x4 u0 = *(const u32x4*)(Ub + (size_t)tid * DM + g * GC), u1 = *(const u32x4*)(Ub + (size_t)tid * DM + g * GC + 8);
    for (int blk = 0; blk < 17; ++blk) {
        { LAS bf16_t* d = Ul + (tid >> 4) * SSM_UST + (tid & 15) * 16; *(LAS u32x4*)d = u0; *(LAS u32x4*)(d + 8) = u1; }
        __syncthreads();
        if (blk + 1 < 17) { const bf16_t* s = Ub + (size_t)(512 * (blk + 1) + tid) * DM + g * GC; u0 = *(const u32x4*)s; u1 = *(const u32x4*)(s + 8); }
#pragma unroll
        for (int nb = 0; nb < 2; ++nb) { f32x4 s = (f32x4){0.f, 0.f, 0.f, 0.f};
            bf16x8 ub[8];
#pragma unroll
            for (int ks = 0; ks < 8; ++ks) ub[ks] = *(const LAS bf16x8*)(Ul + (16 * nb + fr) * SSM_UST + 32 * ks + 8 * fq);
#pragma unroll
            for (int ks = 0; ks < 8; ++ks) s = __builtin_amdgcn_mfma_f32_16x16x32_bf16(ef[ks], ub[ks], s, 0, 0, 0);
#pragma unroll
            for (int r = 0; r < 4; ++r) Sl[(16 * w + 4 * fq + r) * 33 + 16 * nb + fr] = s[r]; }
        __syncthreads();
        if (w == 0) {
            float sr[32], si[32];
#pragma unroll
            for (int c = 0; c < 32; ++c) { sr[c] = Sl[lane * 33 + c]; si[c] = Sl[(64 + lane) * 33 + c]; }
            if (blk < 16) {
#pragma unroll
                for (int c = 0; c < 32; ++c) { Hl[c * SSM_HST + lane] = (bf16_t)f2bf(hr); Hl[c * SSM_HST + 64 + lane] = (bf16_t)f2bf(hi);
                    const float nr = a16r * hr - a16i * hi + sr[c], ni = a16r * hi + a16i * hr + si[c]; hr = nr; hi = ni; }
                if (blk == 15 && hf == 0) { a.out[O_REP + g * NP + lane] = hr; a.out[O_IMP + g * NP + lane] = hi; }
            } else {
#pragma unroll 4
                for (int b = 0; b < 32; ++b) { const float h0r = a.in[2][((size_t)b * NG + g) * NP + lane], h0i = a.in[3][((size_t)b * NG + g) * NP + lane];
                    Hl[b * SSM_HST + lane] = (bf16_t)f2bf(h0r); Hl[b * SSM_HST + 64 + lane] = (bf16_t)f2bf(h0i);
                    if (hf == 0) { a.out[O_RES + ((size_t)b * NG + g) * NP + lane] = a16r * h0r - a16i * h0i + sr[b]; a.out[O_IMS + ((size_t)b * NG + g) * NP + lane] = a16r * h0i + a16i * h0r + si[b]; } }
            }
        }
        __syncthreads();
#pragma unroll
        for (int nb = 0; nb < 2; ++nb) {
            bf16x8 hb[4], ub[8];
#pragma unroll
            for (int ks = 0; ks < 8; ++ks) ub[ks] = *(const LAS bf16x8*)(Ul + (16 * nb + fr) * SSM_UST + 32 * ks + 8 * fq);
#pragma unroll
            for (int kk = 0; kk < 4; ++kk) hb[kk] = *(const LAS bf16x8*)(Hl + (16 * nb + fr) * SSM_HST + 32 * kk + 8 * fq);
            f32x4 y = (f32x4){0.f, 0.f, 0.f, 0.f};
#pragma unroll
            for (int ks = 0; ks < 8; ++ks) if (ks <= iw) y = __builtin_amdgcn_mfma_f32_16x16x32_bf16(mf[ks], ub[ks], y, 0, 0, 0);
#pragma unroll
            for (int kk = 0; kk < 4; ++kk) y = __builtin_amdgcn_mfma_f32_16x16x32_bf16(mf[8 + kk], hb[kk], y, 0, 0, 0);
            const int ch = 16 * nb + fr;
            const u32x2 uu = *(const LAS u32x2*)(Ul + ch * SSM_UST + 16 * ti + 4 * fq);
            const f32x4 uf = (f32x4){bflo(uu.x), bfhi(uu.x), bflo(uu.y), bfhi(uu.y)};
            y += dsk * uf;
            u32x2 o; o.x = pk2(gelu_fast(y[0]), gelu_fast(y[1])); o.y = pk2(gelu_fast(y[2]), gelu_fast(y[3]));
            *(u32x2*)(Yg + (size_t)(512 * blk + 16 * ch + ti) * DM + g * GC + 4 * fq) = o;
        }
        __syncthreads();
    }
    }
}

namespace att {
typedef float f32x8 __attribute__((ext_vector_type(8)));
typedef short s16x4 __attribute__((ext_vector_type(4)));
constexpr float THR = 8.f;
constexpr int KIMG = 16384, KSLOT = 2 * KIMG, VSLOT = 32768, V_OFF = 2 * KSLOT;
constexpr int Q_OFF = 131072 + 1024;
constexpr int OFFS_OFF = 131072 + 2048;
static_assert(OFFS_OFF + 512 * 32 <= LDS_BYTES, "attention LDS map");
typedef float f32x2_t __attribute__((ext_vector_type(2))); typedef __bf16 bf16x2_t __attribute__((ext_vector_type(2)));
__device__ __forceinline__ unsigned cvtpk(float lo, float hi) { f32x2_t v = {lo, hi}; bf16x2_t b = __builtin_convertvector(v, bf16x2_t); return __builtin_bit_cast(unsigned, b); }
__device__ __forceinline__ bf16x8 tobf(const f32x8& x) { u32x4 w = {cvtpk(x[0], x[1]), cvtpk(x[2], x[3]), cvtpk(x[4], x[5]), cvtpk(x[6], x[7])}; return __builtin_bit_cast(bf16x8, w); }
__device__ __forceinline__ int fK(int row) { return (((row >> 3) & 3) << 2) | (row & 3); }
__device__ __forceinline__ int xV(int row) { return (((row >> 3) & 3) << 3) | ((row & 3) << 1); }
__device__ __forceinline__ int k_st(int row, int c) { return row * 256 + 16 * (c ^ fK(row)); }
__device__ __forceinline__ int v_st(int row, int c) { return row * 512 + 16 * (c ^ xV(row)); }
__device__ __forceinline__ float grp_max(float v) {
    { auto rr = __builtin_amdgcn_permlane16_swap(__float_as_uint(v), __float_as_uint(v), false, false); v = fmaxf(__uint_as_float(rr[0]), __uint_as_float(rr[1])); }
    { auto rr = __builtin_amdgcn_permlane32_swap(__float_as_uint(v), __float_as_uint(v), false, false); v = fmaxf(__uint_as_float(rr[0]), __uint_as_float(rr[1])); }
    return v;
}
__device__ __forceinline__ float grp_sum(float v) {
    { auto rr = __builtin_amdgcn_permlane16_swap(__float_as_uint(v), __float_as_uint(v), false, false); v = __uint_as_float(rr[0]) + __uint_as_float(rr[1]); }
    { auto rr = __builtin_amdgcn_permlane32_swap(__float_as_uint(v), __float_as_uint(v), false, false); v = __uint_as_float(rr[0]) + __uint_as_float(rr[1]); }
    return v;
}
struct Rd { int ka[4]; int vb; int vk; };
__device__ __forceinline__ void make_rd(Rd& R, int lane) {
    const int i = lane & 15, dq = lane >> 4;
#pragma unroll
    for (int ds = 0; ds < 4; ++ds) R.ka[ds] = (8 * (i >> 2) + (i & 3)) * 256 + 16 * (dq ^ (i & 3)) + 64 * (ds ^ (i >> 2));
    const int g = lane >> 4, q = (lane & 15) >> 2, p = lane & 3;
    R.vb = (8 * g + q) * 512 + 16 * (p >> 1) + 8 * (p & 1); R.vk = 4 * g + q;
}
__device__ __forceinline__ void scores(f32x4 (&s)[4], const LAS unsigned char* Kimg, const Rd& R, const bf16x8 (&q16)[4], float m_ref) {
#pragma unroll
    for (int kb = 0; kb < 4; ++kb) { s[kb] = (f32x4){-m_ref, -m_ref, -m_ref, -m_ref};
#pragma unroll
        for (int ds = 0; ds < 4; ++ds) { const bf16x8 kf = *(const LAS bf16x8*)(Kimg + R.ka[ds] + (32 * (kb >> 1) + 4 * (kb & 1)) * 256);
            s[kb] = __builtin_amdgcn_mfma_f32_16x16x32_bf16(kf, q16[ds], s[kb], 0, 0, 0); } }
}
__device__ __forceinline__ float max3f(float a, float b, float c) { return fmaxf(fmaxf(a, b), c); }
__device__ __forceinline__ void softmax(f32x4 (&s)[4], float& m_reg, float& l_reg, float& alpha, bf16x8 (&pa)[2], bool first) {
    float pmax = fmaxf(max3f(max3f(s[0][0], s[0][1], s[0][2]), max3f(s[0][3], s[1][0], s[1][1]), max3f(s[1][2], s[1][3], s[2][0])),
                       max3f(max3f(s[2][1], s[2][2], s[2][3]), max3f(s[3][0], s[3][1], s[3][2]), s[3][3]));
    pmax = grp_max(pmax);
    if (__builtin_expect(!first && __all(pmax <= THR), 1)) { alpha = 1.f; }
    else { const float d = first ? pmax : fmaxf(pmax, 0.f); alpha = first ? 0.f : __builtin_amdgcn_exp2f(-d); m_reg += d;
#pragma unroll
        for (int kb = 0; kb < 4; ++kb) s[kb] -= d; }
    float ps = 0.f;
#pragma unroll
    for (int kb = 0; kb < 4; ++kb)
#pragma unroll
        for (int r = 0; r < 4; ++r) { s[kb][r] = __builtin_amdgcn_exp2f(s[kb][r]); ps += s[kb][r]; }
    ps = grp_sum(ps);
    l_reg = l_reg * alpha + ps;
#pragma unroll
    for (int st = 0; st < 2; ++st) { u32x4 w = {cvtpk(s[2 * st][0], s[2 * st][1]), cvtpk(s[2 * st][2], s[2 * st][3]), cvtpk(s[2 * st + 1][0], s[2 * st + 1][1]), cvtpk(s[2 * st + 1][2], s[2 * st + 1][3])};
        pa[st] = __builtin_bit_cast(bf16x8, w); }
}
template <int OFF> __device__ __forceinline__ s16x4 tr_read(int vb) { s16x4 r; asm volatile("ds_read_b64_tr_b16 %0, %1 offset:%2" : "=&v"(r) : "v"(vb), "i"(OFF) : "memory"); return r; }
#define VFR(lo, hi) (bf16x8){lo[0], lo[1], lo[2], lo[3], hi[0], hi[1], hi[2], hi[3]}
struct NoFill { __device__ __forceinline__ void operator()(int) const {} };
template <class Fill> __device__ __forceinline__ void pv2(f32x4 (&o1)[16], f32x4 (&o2)[16], int vbase, const Rd& R, const bf16x8 (&p1)[2], const bf16x8 (&p2)[2], const Fill& fill) {
    int vk = R.vk, vb = R.vb + vbase; asm volatile("" : "+v"(vk), "+v"(vb));
    s16x4 a0, a1, b0, b1, c0, c1, d0, d1;
    { const int v0 = vb + 32 * (0 ^ vk); a0 = tr_read<0>(v0); a1 = tr_read<4 * 512>(v0); b0 = tr_read<32 * 512>(v0); b1 = tr_read<36 * 512>(v0); }
#pragma unroll
    for (int cb = 0; cb < 16; cb += 2) {
        { const int v1 = vb + 32 * ((cb + 1) ^ vk); c0 = tr_read<0>(v1); c1 = tr_read<4 * 512>(v1); d0 = tr_read<32 * 512>(v1); d1 = tr_read<36 * 512>(v1); }
        asm volatile("s_waitcnt lgkmcnt(4)" : "+v"(a0), "+v"(a1), "+v"(b0), "+v"(b1) :: "memory"); __builtin_amdgcn_sched_barrier(0);
        { const bf16x8 fa = VFR(a0, a1), fb = VFR(b0, b1);
          o1[cb] = __builtin_amdgcn_mfma_f32_16x16x32_bf16(fa, p1[0], o1[cb], 0, 0, 0); o2[cb] = __builtin_amdgcn_mfma_f32_16x16x32_bf16(fa, p2[0], o2[cb], 0, 0, 0);
          o1[cb] = __builtin_amdgcn_mfma_f32_16x16x32_bf16(fb, p1[1], o1[cb], 0, 0, 0); o2[cb] = __builtin_amdgcn_mfma_f32_16x16x32_bf16(fb, p2[1], o2[cb], 0, 0, 0); }
        __builtin_amdgcn_sched_barrier(0);
        if (cb + 2 < 16) { const int v0 = vb + 32 * ((cb + 2) ^ vk); a0 = tr_read<0>(v0); a1 = tr_read<4 * 512>(v0); b0 = tr_read<32 * 512>(v0); b1 = tr_read<36 * 512>(v0);
            asm volatile("s_waitcnt lgkmcnt(4)" : "+v"(c0), "+v"(c1), "+v"(d0), "+v"(d1) :: "memory"); }
        else asm volatile("s_waitcnt lgkmcnt(0)" : "+v"(c0), "+v"(c1), "+v"(d0), "+v"(d1) :: "memory");
        __builtin_amdgcn_sched_barrier(0);
        { const bf16x8 fc = VFR(c0, c1), fd = VFR(d0, d1);
          o1[cb + 1] = __builtin_amdgcn_mfma_f32_16x16x32_bf16(fc, p1[0], o1[cb + 1], 0, 0, 0); o2[cb + 1] = __builtin_amdgcn_mfma_f32_16x16x32_bf16(fc, p2[0], o2[cb + 1], 0, 0, 0);
          o1[cb + 1] = __builtin_amdgcn_mfma_f32_16x16x32_bf16(fd, p1[1], o1[cb + 1], 0, 0, 0); o2[cb + 1] = __builtin_amdgcn_mfma_f32_16x16x32_bf16(fd, p2[1], o2[cb + 1], 0, 0, 0); }
        fill(cb >> 1);
        __builtin_amdgcn_sched_barrier(0);
    }
}
__device__ __forceinline__ void pv1(f32x4 (&o)[16], int vbase, const Rd& R, const bf16x8 (&p)[2]) {
    int vk = R.vk, vb = R.vb + vbase; asm volatile("" : "+v"(vk), "+v"(vb));
    s16x4 a0, a1, b0, b1, c0, c1, d0, d1;
    { const int v0 = vb + 32 * (0 ^ vk); a0 = tr_read<0>(v0); a1 = tr_read<4 * 512>(v0); b0 = tr_read<32 * 512>(v0); b1 = tr_read<36 * 512>(v0); }
#pragma unroll
    for (int cb = 0; cb < 16; cb += 2) {
        { const int v1 = vb + 32 * ((cb + 1) ^ vk); c0 = tr_read<0>(v1); c1 = tr_read<4 * 512>(v1); d0 = tr_read<32 * 512>(v1); d1 = tr_read<36 * 512>(v1); }
        asm volatile("s_waitcnt lgkmcnt(4)" : "+v"(a0), "+v"(a1), "+v"(b0), "+v"(b1) :: "memory"); __builtin_amdgcn_sched_barrier(0);
        o[cb] = __builtin_amdgcn_mfma_f32_16x16x32_bf16(VFR(a0, a1), p[0], o[cb], 0, 0, 0); o[cb] = __builtin_amdgcn_mfma_f32_16x16x32_bf16(VFR(b0, b1), p[1], o[cb], 0, 0, 0);
        __builtin_amdgcn_sched_barrier(0);
        if (cb + 2 < 16) { const int v0 = vb + 32 * ((cb + 2) ^ vk); a0 = tr_read<0>(v0); a1 = tr_read<4 * 512>(v0); b0 = tr_read<32 * 512>(v0); b1 = tr_read<36 * 512>(v0);
            asm volatile("s_waitcnt lgkmcnt(4)" : "+v"(c0), "+v"(c1), "+v"(d0), "+v"(d1) :: "memory"); }
        else asm volatile("s_waitcnt lgkmcnt(0)" : "+v"(c0), "+v"(c1), "+v"(d0), "+v"(d1) :: "memory");
        __builtin_amdgcn_sched_barrier(0);
        o[cb + 1] = __builtin_amdgcn_mfma_f32_16x16x32_bf16(VFR(c0, c1), p[0], o[cb + 1], 0, 0, 0); o[cb + 1] = __builtin_amdgcn_mfma_f32_16x16x32_bf16(VFR(d0, d1), p[1], o[cb + 1], 0, 0, 0);
        __builtin_amdgcn_sched_barrier(0);
    }
}
#undef VFR
struct Ctx { const bf16_t* Qb; const bf16_t* Kb; const bf16_t* Vb; const bf16_t* SZ2; bf16_t* Ab; const float* ck; const float* cv; const float* subln; float lam; };

__device__ __forceinline__ void finish_rows(const Ctx& C, f32x4 (&o1)[16], const f32x4 (&o2)[16], float l1, float l2, int row, int h, int lane) {
    int g = lane >> 4; asm volatile("" : "+v"(g));
    const float f1 = 1.f / l1, f2 = -C.lam / l2; float ss = 0.f;
#pragma unroll
    for (int cb = 0; cb < 16; ++cb) { o1[cb] = o1[cb] * f1 + o2[cb] * f2; ss += (o1[cb][0] * o1[cb][0] + o1[cb][1] * o1[cb][1]) + (o1[cb][2] * o1[cb][2] + o1[cb][3] * o1[cb][3]); }
    ss = grp_sum(ss);
    const float rr = (1.0f / sqrtf(ss * (1.0f / 256.0f) + EPS)) * (1.0f - LAMBDA_INIT);
    const size_t rowoff = (size_t)row * DM + h * 256 + 4 * g;
#pragma unroll
    for (int cb = 0; cb < 16; ++cb) { const f32x4 sg = *(const f32x4*)(C.subln + 16 * cb + 4 * g); const u32x2 z = *(const u32x2*)(C.SZ2 + rowoff + 16 * cb);
        u32x2 ov; ov.x = pk2(o1[cb][0] * rr * sg[0] * bflo(z.x), o1[cb][1] * rr * sg[1] * bfhi(z.x)); ov.y = pk2(o1[cb][2] * rr * sg[2] * bflo(z.y), o1[cb][3] * rr * sg[3] * bfhi(z.y));
        *(u32x2*)(C.Ab + rowoff + 16 * cb) = ov; }
}
__device__ __forceinline__ void glds16(const void* gsrc, unsigned lds_dst) { unsigned keep;
    asm volatile("s_mov_b32 %0, m0\n\ts_mov_b32 m0, %2\n\ts_nop 0\n\tglobal_load_lds_dwordx4 %1, off\n\ts_mov_b32 m0, %0" : "=&s"(keep) : "v"(gsrc), "s"(lds_dst) : "memory"); }
#define WAIT_BAR(N) asm volatile("s_waitcnt vmcnt(" #N ") lgkmcnt(0)\n\ts_barrier" ::: "memory")
#define RFL(x) ((unsigned)__builtin_amdgcn_readfirstlane((int)(x)))
#define ATT_SCALE(o, a) do { _Pragma("unroll") for (int cb_ = 0; cb_ < 16; ++cb_) o[cb_] *= (a); } while (0)

template <int MODE> __device__ __forceinline__ void prompt_unit(const Ctx& C, LAS unsigned char* lds, int c, int h, int tid) {
    const int w = __builtin_amdgcn_readfirstlane(tid >> 6), lane = tid & 63;
    Rd R; make_rd(R, lane);
    bf16x8 q1[4], q2[4];
    { const bf16_t* Qw = C.Qb + (size_t)(128 * c + 16 * w + (lane & 15)) * DM + h * 256 + 8 * (lane >> 4);
#pragma unroll
      for (int ds = 0; ds < 4; ++ds) { q1[ds] = *(const bf16x8*)(Qw + 32 * ds); q2[ds] = *(const bf16x8*)(Qw + 128 + 32 * ds); } }
    const bf16_t* Kh = C.Kb + h * 256; const bf16_t* Vh = C.Vb + h * 256;
    const unsigned ldsb = (unsigned)(uintptr_t)lds;
    const unsigned kdst = ldsb + (unsigned)(w >> 2) * KIMG + (unsigned)(w & 3) * 4096u, vdst = ldsb + V_OFF + (unsigned)w * 4096u;
    const LAS u32x4* offs = (const LAS u32x4*)(lds + OFFS_OFF + tid * 32);
    auto dma_piece = [&](int k, int t, int b, const u32x4& ko, const u32x4& vo) {
        if (MODE >= 3 && MODE != 4) return;
        if (k < 4) glds16(Kh + (size_t)t * 64 * DM + ko[k], RFL(kdst + (unsigned)b * KSLOT + (unsigned)k * 1024u));
        else glds16(Vh + (size_t)t * 64 * DM + vo[k - 4], RFL(vdst + (unsigned)b * VSLOT + (unsigned)(k - 4) * 1024u)); };
    const int vb0 = (int)(uintptr_t)(lds + V_OFF);
    const int NT = 2 * c + 2, myNT = NT - (w < 4 ? 1 : 0);
    float m1 = 0.f, l1 = 0.f, m2 = 0.f, l2 = 0.f, al1 = 1.f, al2 = 1.f; f32x4 o1[16], o2[16]; f32x4 s[4]; bf16x8 pa1[2], pa2[2];
#pragma unroll
    for (int cb = 0; cb < 16; ++cb) { o1[cb] = (f32x4){0.f, 0.f, 0.f, 0.f}; o2[cb] = (f32x4){0.f, 0.f, 0.f, 0.f}; }
    { const u32x4 ko = offs[0], vo = offs[1];
#pragma unroll
      for (int k = 0; k < 8; ++k) dma_piece(k, 0, 0, ko, vo); }
    WAIT_BAR(0);
    for (int j = 0; j < NT; ++j) {
        const bool more = j + 1 < NT;
        const u32x4 ko = offs[0], vo = offs[1];
        auto fill = [&](int k) { if (more) dma_piece(k, j + 1, (j + 1) & 1, ko, vo); };
        if (j < myNT && MODE != 4 && MODE != 7) {
            if (MODE != 6) {
            scores(s, lds + (j & 1) * KSLOT, R, q1, m1); fill(0); fill(1); softmax(s, m1, l1, al1, pa1, j == 0); fill(2); fill(3);
            scores(s, lds + (j & 1) * KSLOT + KIMG, R, q2, m2); fill(4); fill(5); softmax(s, m2, l2, al2, pa2, j == 0); fill(6); fill(7);
            if (__any(al1 < 1.f)) ATT_SCALE(o1, al1);
            if (__any(al2 < 1.f)) ATT_SCALE(o2, al2); }
            else { _Pragma("unroll") for (int k = 0; k < 8; ++k) fill(k); }
            if (MODE != 5) pv2(o1, o2, vb0 + (j & 1) * VSLOT, R, pa1, pa2, NoFill{});
        } else {
#pragma unroll
            for (int k = 0; k < 8; ++k) fill(k);
        }
        WAIT_BAR(0);
    }
    finish_rows(C, o1, o2, l1, l2, 128 * c + 16 * w + (lane & 15), h, lane);
}

__device__ __forceinline__ void sample_unit(const Ctx& C, LAS unsigned char* lds, int b, int h, int tid) {
    const int w = __builtin_amdgcn_readfirstlane(tid >> 6), lane = tid & 63;
    const int row0 = MP + DS * b;
    if ((w & 3) >= 2) {
        const int lt = (((w >> 2) << 1) | (w & 1)) * 64 + lane, sr = lt >> 4, sc = (lt & 15) * 8;
        const float* kp = C.ck + (((size_t)b * PAST + sr) * NH + h) * 256 + sc; const float* vp = C.cv + (((size_t)b * PAST + sr) * NH + h) * 256 + sc;
        constexpr size_t RS = (size_t)NH * 256;
        f32x8 kf[8], vf[8];
#define LLOAD(t) do { const size_t ro = (size_t)(t) * 64 * RS; _Pragma("unroll") for (int i = 0; i < 4; ++i) { kf[2 * i] = *(const f32x8*)(kp + ro + (size_t)(16 * i) * RS); kf[2 * i + 1] = *(const f32x8*)(kp + ro + (size_t)(16 * i) * RS + 128); \
            vf[2 * i] = *(const f32x8*)(vp + ro + (size_t)(16 * i) * RS); vf[2 * i + 1] = *(const f32x8*)(vp + ro + (size_t)(16 * i) * RS + 128); } } while (0)
        LLOAD(0);
        for (int t = 0; t < 32; ++t) {
            LAS unsigned char* Kd = lds + (t & 1) * KSLOT; LAS unsigned char* Vd = lds + V_OFF + (t & 1) * VSLOT;
#pragma unroll
            for (int i = 0; i < 4; ++i) { const int kr = sr + 16 * i;
                *(LAS bf16x8*)(Kd + k_st(kr, sc >> 3)) = tobf(kf[2 * i]); *(LAS bf16x8*)(Kd + KIMG + k_st(kr, sc >> 3)) = tobf(kf[2 * i + 1]);
                *(LAS bf16x8*)(Vd + v_st(kr, sc >> 3)) = tobf(vf[2 * i]); *(LAS bf16x8*)(Vd + v_st(kr, 16 + (sc >> 3))) = tobf(vf[2 * i + 1]); }
            if (t + 1 < 32) LLOAD(t + 1);
            __syncthreads();
        }
#undef LLOAD
        { LAS unsigned char* Kd = lds; LAS unsigned char* Vd = lds + V_OFF;
#pragma unroll
          for (int i = 0; i < 4; ++i) { const int kr = sr + 16 * i; const bf16_t* ks = C.Kb + (size_t)(row0 + kr) * DM + h * 256 + sc; const bf16_t* vs = C.Vb + (size_t)(row0 + kr) * DM + h * 256 + sc;
              bf16x8 k0 = *(const bf16x8*)ks, k1 = *(const bf16x8*)(ks + 128), v0 = *(const bf16x8*)vs, v1 = *(const bf16x8*)(vs + 128);
              if (kr >= DS) { v0 = bf16x8{}; v1 = bf16x8{}; k0 = bf16x8{}; k1 = bf16x8{}; }
              *(LAS bf16x8*)(Kd + k_st(kr, sc >> 3)) = k0; *(LAS bf16x8*)(Kd + KIMG + k_st(kr, sc >> 3)) = k1;
              *(LAS bf16x8*)(Vd + v_st(kr, sc >> 3)) = v0; *(LAS bf16x8*)(Vd + v_st(kr, 16 + (sc >> 3))) = v1; } }
        __syncthreads();
    } else if ((w & 3) == 0) {
        const int n = w >> 2;
        Rd R; make_rd(R, lane);
        bf16x8 q[4];
        { const bf16_t* Qw = C.Qb + (size_t)(row0 + (lane & 15)) * DM + h * 256 + 128 * n + 8 * (lane >> 4);
#pragma unroll
          for (int ds = 0; ds < 4; ++ds) q[ds] = *(const bf16x8*)(Qw + 32 * ds); }
        const int vb0 = (int)(uintptr_t)(lds + V_OFF);
        float m = 0.f, l = 0.f, al; f32x4 o[16]; f32x4 s[4]; bf16x8 pa[2];
#pragma unroll
        for (int cb = 0; cb < 16; ++cb) o[cb] = (f32x4){0.f, 0.f, 0.f, 0.f};
        for (int t = 0; t < 33; ++t) {
            __syncthreads();
            scores(s, lds + (t & 1) * KSLOT + n * KIMG, R, q, m);
            if (t == 32) {
#pragma unroll
                for (int kb = 0; kb < 4; ++kb) if (kb >= 2 || (lane >> 4) >= 2) s[kb] = (f32x4){-1e30f, -1e30f, -1e30f, -1e30f}; }
            softmax(s, m, l, al, pa, t == 0);
            if (__any(al < 1.f)) ATT_SCALE(o, al);
            pv1(o, vb0 + (t & 1) * VSLOT, R, pa);
        }
        const float f = (n == 0 ? 1.f : -C.lam) / l;
        ATT_SCALE(o, f);
        LAS float* X = (LAS float*)lds;
        __syncthreads();
        if (n == 1) {
#pragma unroll
            for (int cb = 0; cb < 16; ++cb) *(LAS f32x4*)(X + (cb * 64 + lane) * 4) = o[cb]; }
        __syncthreads();
        if (n == 0) {
            int g = lane >> 4; asm volatile("" : "+v"(g)); float ss = 0.f;
#pragma unroll
            for (int cb = 0; cb < 16; ++cb) { o[cb] += *(const LAS f32x4*)(X + (cb * 64 + lane) * 4); ss += (o[cb][0] * o[cb][0] + o[cb][1] * o[cb][1]) + (o[cb][2] * o[cb][2] + o[cb][3] * o[cb][3]); }
            ss = grp_sum(ss);
            const float rr = (1.0f / sqrtf(ss * (1.0f / 256.0f) + EPS)) * (1.0f - LAMBDA_INIT);
            const size_t rowoff = (size_t)(row0 + (lane & 15)) * DM + h * 256 + 4 * g;
#pragma unroll
            for (int cb = 0; cb < 16; ++cb) { const f32x4 sg = *(const f32x4*)(C.subln + 16 * cb + 4 * g); const u32x2 z = *(const u32x2*)(C.SZ2 + rowoff + 16 * cb);
                u32x2 ov; ov.x = pk2(o[cb][0] * rr * sg[0] * bflo(z.x), o[cb][1] * rr * sg[1] * bfhi(z.x)); ov.y = pk2(o[cb][2] * rr * sg[2] * bflo(z.y), o[cb][3] * rr * sg[3] * bfhi(z.y));
                *(u32x2*)(C.Ab + rowoff + 16 * cb) = ov; } }
    } else {
        for (int t = 0; t < 33; ++t) __syncthreads();
    }
    if ((w & 3) != 0) { __syncthreads(); __syncthreads(); }
    __syncthreads();
}
#undef WAIT_BAR
#undef RFL
#undef ATT_SCALE
}

constexpr int CW_ATTQ = 2048;
constexpr int ATT_PER_HEAD = 64 + DB;
__device__ __forceinline__ void att_decode(int pos, bool& samp, int& a) {
    if (pos < 64) { samp = pos & 1; a = samp ? (pos >> 1) : 63 - (pos >> 1); return; }
    samp = false; a = 63 - (32 + (pos - 64));
}
template <int MODE> __device__ __forceinline__ void p6_attn(Frame& F, const Args& a, int rep) {
    unsigned char* ws = a.ws;
    att::Ctx C{(const bf16_t*)(ws + WS_QB), (const bf16_t*)(ws + WS_KB), (const bf16_t*)(ws + WS_VB), (const bf16_t*)(ws + WS_SZ2), (bf16_t*)(ws + WS_AB), a.in[4], a.in[5], a.in[26], ((const float*)(ws + WS_SMALL + SM_LAM))[0]};
    volatile LAS int* qw = (volatile LAS int*)(F.lds + att::Q_OFF);
    { const int w = F.wave, lane = F.lane; u32x4 ko, vo;
#pragma unroll
      for (int pc = 0; pc < 4; ++pc) { { const int L = (4 * (w & 3) + pc) * 1024 + lane * 16, row = L >> 8, cc = (lane & 15) ^ att::fK(row); ko[pc] = (unsigned)row * DM + 128 * (w >> 2) + 8 * cc; }
          { const int L = (4 * w + pc) * 1024 + lane * 16, row = L >> 9, cc = ((L >> 4) & 31) ^ att::xV(row); vo[pc] = (unsigned)row * DM + 8 * cc; } }
      LAS u32x4* o = (LAS u32x4*)(F.lds + att::OFFS_OFF + F.tid * 32); o[0] = ko; o[1] = vo; }
    __syncthreads();
    const int x = (int)(xb_xcc_id() & 7u);
    for (int k = 0; k < NH; ++k) {
        const int h = (x + k) & 7;
        for (;;) {
            if (F.tid == 0) *qw = (int)__hip_atomic_fetch_add((unsigned*)(F.ctl + CW_ATTQ + (rep * NH + h) * 16), 1u, __ATOMIC_RELAXED, __HIP_MEMORY_SCOPE_AGENT);
            __syncthreads();
            const int pos = *qw;
            __syncthreads();
            if (pos >= ATT_PER_HEAD) break;
            bool samp; int ua; att_decode(pos, samp, ua);
            if ((MODE != 0 && MODE != 2 && samp) || (MODE == 2 && !samp)) continue;
            if (samp) att::sample_unit(C, F.lds, ua, h, F.tid); else att::prompt_unit<MODE>(C, F.lds, ua, h, F.tid);
        }
    }
}

template <bool PERM5> __device__ __forceinline__ void p0_transpose_item(const float* W, const float* g, int K, int N, bf16_t* WT, int row_off, LAS float* scr, int item, int lane) {
    const int nblk = N / 64, kb = item / nblk, nb = item % nblk, k0 = 32 * kb, n0 = 64 * nb;
    f32x4 v[8];
#pragma unroll
    for (int i = 0; i < 8; ++i) v[i] = *(const f32x4*)(W + (size_t)(k0 + 4 * i + (lane >> 4)) * N + n0 + 4 * (lane & 15));
#pragma unroll
    for (int i = 0; i < 8; ++i) *(LAS f32x4*)(scr + (4 * i + (lane >> 4)) * 68 + 4 * (lane & 15)) = v[i];
    const int c = lane & 3;
    f32x4 g0 = (f32x4){1.f, 1.f, 1.f, 1.f}, g1 = g0;
    if (g) { g0 = *(const f32x4*)(g + k0 + 8 * c); g1 = *(const f32x4*)(g + k0 + 8 * c + 4); }
    LDS_WAIT(); asm volatile("" ::: "memory");
#pragma unroll
    for (int j = 0; j < 4; ++j) { const int n = (lane >> 2) + 16 * j; const LAS float* s = scr + (8 * c) * 68 + n;
        u32x4 o; o.x = pk2(s[0 * 68] * g0[0], s[1 * 68] * g0[1]); o.y = pk2(s[2 * 68] * g0[2], s[3 * 68] * g0[3]); o.z = pk2(s[4 * 68] * g1[0], s[5 * 68] * g1[1]); o.w = pk2(s[6 * 68] * g1[2], s[7 * 68] * g1[3]);
        const int row = row_off + (PERM5 ? wt5_row(n0 + n) : n0 + n);
        *(u32x4*)(WT + (size_t)row * K + k0 + 8 * c) = o; }
    LDS_WAIT(); asm volatile("" ::: "memory");
}
__device__ __forceinline__ void p0_row(const float* xrow, bf16_t* orow, float* rs, int lane) {
    const f32x4* xr = (const f32x4*)xrow + lane;
    f32x4 v[8]; float s = 0.f;
#pragma unroll
    for (int j = 0; j < 8; ++j) { v[j] = xr[64 * j]; s += (v[j].x * v[j].x + v[j].y * v[j].y) + (v[j].z * v[j].z + v[j].w * v[j].w); }
    s = wave_sum(s);
    if (lane == 0) *rs = 1.0f / sqrtf(s * (1.0f / DM) + EPS);
    unsigned long long* o8 = (unsigned long long*)orow + lane;
#pragma unroll
    for (int j = 0; j < 8; ++j) o8[64 * j] = (unsigned long long)pk2(v[j].x, v[j].y) | ((unsigned long long)pk2(v[j].z, v[j].w) << 32);
}
__device__ __forceinline__ void p0_prologue(Frame& F, const Args& a) {
    unsigned char* ws = a.ws;
    LAS float* scr = (LAS float*)(F.lds + RING_OFF + F.wave * 16384);
    const int gw = F.vcu * NWAVES + F.wave, NGW = F.G * NWAVES;
    bf16_t *Wt1 = (bf16_t*)(ws + WS_WT1), *Wtg = (bf16_t*)(ws + WS_WTG), *Wto = (bf16_t*)(ws + WS_WTO), *Wt5 = (bf16_t*)(ws + WS_WT5), *Wtb = (bf16_t*)(ws + WS_WTB);
    constexpr int I_BIG = (DM / 32) * (4096 / 64), I_SQ = (DM / 32) * (DM / 64);
    constexpr int NITEMS = 3 * I_BIG + 3 * I_SQ;
    for (int it = gw; it < NITEMS; it += NGW) {
        int r = it;
        if (r < I_BIG) { p0_transpose_item<false>(a.in[7], a.in[6], DM, 4096, Wt1, 0, scr, r, F.lane); continue; } r -= I_BIG;
        if (r < I_BIG) { p0_transpose_item<true>(a.in[19], a.in[18], DM, 4096, Wt5, 0, scr, r, F.lane); continue; } r -= I_BIG;
        if (r < I_BIG) { p0_transpose_item<true>(a.in[21], a.in[20], DM, 4096, Wt5, 4096, scr, r, F.lane); continue; } r -= I_BIG;
        if (r < I_SQ) { p0_transpose_item<false>(a.in[16], nullptr, DM, DM, Wtg, 0, scr, r, F.lane); continue; } r -= I_SQ;
        if (r < I_SQ) { p0_transpose_item<false>(a.in[17], nullptr, DM, DM, Wto, 0, scr, r, F.lane); continue; } r -= I_SQ;
        p0_transpose_item<false>(a.in[27], nullptr, DM, DM, Wtb, 0, scr, r, F.lane);
    }
    for (int it = gw; it < NG * 16; it += NGW) p0_ssm_item(a, it >> 4, it & 15, scr, F.lane);
    bf16_t* Xb = (bf16_t*)(ws + WS_XB); float* rs0 = (float*)(ws + WS_RS0);
    for (int m = gw; m < M; m += NGW) p0_row(m < MP ? a.in[0] + (size_t)m * DM : a.in[1] + (size_t)(m - MP) * DM, Xb + (size_t)m * DM, rs0 + m, F.lane);
    const int gt = F.vcu * (NWAVES * 64) + F.tid, NGT = F.G * NWAVES * 64;
    float* lam = (float*)(ws + WS_SMALL + SM_LAM);
    { float* z1 = (float*)(ws + WS_SSQ1) + (size_t)MP * NSSQ; float* z2 = (float*)(ws + WS_SSQ2) + (size_t)MP * NSSQ;
      for (int i = gt; i < MS * NSSQ; i += NGT) { z1[i] = 0.f; z2[i] = 0.f; } }
    float* rope = (float*)(ws + WS_ROPE);
    for (int idx = gt; idx < SEQ * 64; idx += NGT) {
        const int pos = idx >> 6, i = idx & 63;
        const float inv = (float)pow(10000.0, -(double)(2 * i) / 128.0);
        const float ang = (float)pos * inv;
        rope[idx] = (float)cos((double)ang); rope[(size_t)SEQ * 64 + idx] = (float)sin((double)ang);
    }
    if (blockIdx.x == 0 && F.tid == 0) { float s1 = 0.f, s2 = 0.f; for (int i = 0; i < HD; ++i) { s1 += a.in[22][i] * a.in[23][i]; s2 += a.in[24][i] * a.in[25][i]; } lam[0] = expf(s1) - expf(s2) + LAMBDA_INIT; }
}
__device__ __forceinline__ void p8_final(Frame& F, const Args& a) {
    const int gw = F.vcu * NWAVES + F.wave, NGW = F.G * NWAVES;
    const float* X2 = (const float*)(a.ws + WS_X2); const float* ssq = (const float*)(a.ws + WS_SSQ2); const f32x4* gn = (const f32x4*)a.in[28] + F.lane;
    for (int m = gw; m < M; m += NGW) {
        const f32x4* xr = (const f32x4*)(X2 + (size_t)m * DM) + F.lane; f32x4* yr = (f32x4*)(a.out + O_YP + (size_t)m * DM) + F.lane;
        float q = (F.lane < NSSQ) ? ssq[(size_t)m * NSSQ + F.lane] : 0.f; q = wave_sum(q);
        const float rs = 1.0f / sqrtf(q * (1.0f / DM) + EPS);
#pragma unroll
        for (int j = 0; j < 8; ++j) yr[64 * j] = xr[64 * j] * rs * gn[64 * j];
    }
}

template <int MODE> __global__ void __launch_bounds__(NWAVES * 64, 2) mk_fwd(Args args) {
    extern __shared__ __attribute__((aligned(16))) unsigned char lds[];
    Frame F;
    F.lds = (LAS unsigned char*)lds;
    F.MISC = (volatile LAS unsigned*)(F.lds + MISC_OFF);
    F.tid = threadIdx.x; F.lane = F.tid & 63; F.wave = __builtin_amdgcn_readfirstlane(F.tid >> 6);
    F.G = gridDim.x; { const int bx = blockIdx.x; F.vcu = (F.G % 8 == 0) ? (bx % 8) * (F.G / 8) + bx / 8 : bx; }
    unsigned char* ws = args.ws;
    F.ctl = (gu32*)(ws + WS_CTL);
    for (int u = F.tid; u < (LDS_BYTES - LDSCTL_OFF) / 4; u += NWAVES * 64) ((LAS unsigned*)(F.lds + LDSCTL_OFF))[u] = 0u;
    __syncthreads();
    XcdBarrier bar = xcd_barrier_post((unsigned*)(F.ctl + CW_BAR) + args.li * XCD_BAR_WORDS, F.MISC + 8);
    const int lo = args.ph_lo, hi = args.ph_hi;
#define IN(k) (lo <= (k) && (k) < hi)
#define REFRESH() do { int t_ = threadIdx.x; asm volatile("" : "+v"(t_)); F.tid = t_; F.lane = t_ & 63; } while (0)
#define BOTH(k) (IN(k) && IN((k) + 1))
    bf16_t *Wt1 = (bf16_t*)(ws + WS_WT1), *Wtg = (bf16_t*)(ws + WS_WTG), *Wto = (bf16_t*)(ws + WS_WTO), *Wt5 = (bf16_t*)(ws + WS_WT5), *Wtb = (bf16_t*)(ws + WS_WTB);
    bf16_t *Xb = (bf16_t*)(ws + WS_XB), *Ub = (bf16_t*)(ws + WS_UB), *SZ = (bf16_t*)(ws + WS_SZ), *Yg = (bf16_t*)(ws + WS_YG), *Ob = (bf16_t*)(ws + WS_OB), *X1b = (bf16_t*)(ws + WS_X1B),
           *Kb = (bf16_t*)(ws + WS_KB), *Vb = (bf16_t*)(ws + WS_VB), *Qb = (bf16_t*)(ws + WS_QB), *SZ2 = (bf16_t*)(ws + WS_SZ2), *Ab = (bf16_t*)(ws + WS_AB);
    float *X1 = (float*)(ws + WS_X1), *X2 = (float*)(ws + WS_X2), *ssq1 = (float*)(ws + WS_SSQ1), *ssq2 = (float*)(ws + WS_SSQ2);

    if (IN(0)) { REFRESH(); p0_prologue(F, args); if (BOTH(0)) xcd_barrier(bar); }
    if (IN(1)) { REFRESH();
        pg8::Gemm g{Xb, Wt1, MP, 4096, DM}; pg8::StaticOrder S; S.init(MP, 4096, F.G, (int)blockIdx.x);
        pg8::EpiUZ E{Ub, SZ, (const float*)(ws + WS_RS0)};
        pg8::gemm_phase<pg8::EpiUZ, pg8::StaticOrder, true, true>(F.lds + RING_OFF, g, S, E);
        sk::phase<4, 64>(F.lds + RING_OFF, Xb, Wt1, 4096, sk::EpiUZ{Ub, SZ, (const float*)(ws + WS_RS0)}, F.vcu, F.G);
        if (BOTH(1)) xcd_barrier(bar);
    }
    if (IN(2)) { REFRESH(); p2_ssm(F, args); if (BOTH(2)) xcd_barrier(bar); }
    if (IN(3)) { REFRESH();
        pg8::Gemm g{Yg, Wtg, MP, DM, DM}; pg8::StaticOrder S; S.init(MP, DM, F.G, (int)blockIdx.x);
        pg8::EpiGlu E{Yg, SZ, Ob};
        pg8::gemm_phase<pg8::EpiGlu, pg8::StaticOrder, true, true>(F.lds + RING_OFF, g, S, E);
        sk::phase<4, 32>(F.lds + RING_OFF, Yg, Wtg, DM, sk::EpiGlu{Yg, SZ, Ob}, F.vcu, F.G);
        if (BOTH(3)) xcd_barrier(bar);
    }
    if (IN(4)) { REFRESH();
        pg8::Gemm g{Ob, Wto, MP, DM, DM}; pg8::StaticOrder S; S.init(MP, DM, F.G, (int)blockIdx.x);
        pg8::EpiRes E{args.in[0], args.in[1], X1, X1b, ssq1};
        pg8::gemm_phase<pg8::EpiRes, pg8::StaticOrder, true, true>(F.lds + RING_OFF, g, S, E);
        sk::phase<4, 32>(F.lds + RING_OFF, Ob, Wto, DM, sk::EpiRes{args.in[1] - (size_t)MP * DM, X1, X1b, ssq1}, F.vcu, F.G);
        if (BOTH(4)) xcd_barrier(bar);
    }
    if (IN(5)) { REFRESH();
        pg8::Gemm g{X1b, Wt5, MP, 8192, DM}; pg8::StaticOrder S; S.init(MP, 8192, F.G, (int)blockIdx.x);
        pg8::EpiKVQZ E{ssq1, (const float*)(ws + WS_ROPE), args.out, Kb, Vb, Qb, SZ2};
        pg8::gemm_phase<pg8::EpiKVQZ, pg8::StaticOrder, true, true>(F.lds + RING_OFF, g, S, E);
        sk::phase<8, 64>(F.lds + RING_OFF, X1b, Wt5, 8192, sk::EpiKVQZ{ssq1, (const float*)(ws + WS_ROPE), args.out, Kb, Vb, Qb, SZ2}, F.vcu, F.G);
        if (BOTH(5)) xcd_barrier(bar);
    }
    if (IN(6)) { REFRESH(); p6_attn<MODE>(F, args, args.li); if (BOTH(6)) xcd_barrier(bar); }
    if (IN(7)) { REFRESH();
        pg8::Gemm g{Ab, Wtb, MP, DM, DM}; pg8::StaticOrder S; S.init(MP, DM, F.G, (int)blockIdx.x);
        pg8::EpiRes E{X1, X1 + (size_t)MP * DM, X2, nullptr, ssq2};
        pg8::gemm_phase<pg8::EpiRes, pg8::StaticOrder, true, true>(F.lds + RING_OFF, g, S, E);
        sk::phase<4, 32>(F.lds + RING_OFF, Ab, Wtb, DM, sk::EpiRes{X1, X2, nullptr, ssq2}, F.vcu, F.G);
        if (BOTH(7)) xcd_barrier(bar);
    }
    if (IN(8)) { REFRESH(); p8_final(F, args); }
#undef IN
#undef BOTH
}

static void launch_mk(int grid, const Args& base, int lo, int hi, int li, hipStream_t stream, int mode = 0) {
    Args a = base; a.ph_lo = lo; a.ph_hi = hi; a.li = li; a.pad = mode;
#ifdef MK_PROBE_MODE
    if (mode == MK_PROBE_MODE) { (void)hipFuncSetAttribute((const void*)mk_fwd<MK_PROBE_MODE>, hipFuncAttributeMaxDynamicSharedMemorySize, LDS_BYTES); hipLaunchKernelGGL(mk_fwd<MK_PROBE_MODE>, dim3(grid), dim3(NWAVES * 64), LDS_BYTES, stream, a); } else
#endif
    hipLaunchKernelGGL(mk_fwd<0>, dim3(grid), dim3(NWAVES * 64), LDS_BYTES, stream, a);
    const hipError_t le = hipPeekAtLastError();
    if (le != hipSuccess) fprintf(stderr, "kernel_launch: launch [%d,%d) failed: %s (grid %d)\n", lo, hi, hipGetErrorName(le), grid);
}
extern "C" void kernel_launch(void* const* d_in, const int* in_sizes, int n_in, void* d_out, int out_size, void* d_ws, size_t ws_size, hipStream_t stream) {
    static int grid = 0;
    if (grid == 0) {
        if (n_in != 29 || (size_t)out_size != O_END || ws_size < WS_END2) { fprintf(stderr, "kernel_launch: unexpected shapes (n_in %d out %d ws %zu)\n", n_in, out_size, ws_size); grid = -1; return; }
        int dev = 0, cus = 0, per_cu = 0;
        if (hipGetDevice(&dev) != hipSuccess || hipDeviceGetAttribute(&cus, hipDeviceAttributeMultiprocessorCount, dev) != hipSuccess) { grid = -1; return; }
        if (hipFuncSetAttribute((const void*)mk_fwd<0>, hipFuncAttributeMaxDynamicSharedMemorySize, LDS_BYTES) != hipSuccess) { fprintf(stderr, "kernel_launch: hipFuncSetAttribute failed\n"); grid = -1; return; }
        if (hipOccupancyMaxActiveBlocksPerMultiprocessor(&per_cu, (const void*)mk_fwd<0>, NWAVES * 64, LDS_BYTES) != hipSuccess || per_cu < 1) { fprintf(stderr, "kernel_launch: occupancy query says %d blocks per CU\n", per_cu); per_cu = 1; }
        (void)hipGetLastError();
        grid = cus;
    }
    if (grid < 0) return;
    if (hipMemsetAsync((char*)d_ws + WS_CTL, 0, CTL_ZERO_BYTES, stream) != hipSuccess) { fprintf(stderr, "kernel_launch: memset failed\n"); return; }
    Args a{};
    for (int i = 0; i < 29; ++i) a.in[i] = (const float*)d_in[i];
    a.out = (float*)d_out; a.ws = (unsigned char*)d_ws;
    launch_mk(grid, a, 0, 9, 0, stream);
#ifdef MK_PROBE_PHASES
    { const int extra[] = {MK_PROBE_PHASES}; int li = 1;
      for (int k : extra) { launch_mk(grid, a, k % 100, k % 100 + 1, li, stream, k / 100); ++li; } }
#endif
}
```

```cpp
#include <hip/hip_runtime.h>
#include <cstdint>
#include <cstdio>
#include <cmath>

constexpr int DM = 2048, SEQ = 8192, DB = 32, DS = 16, PAST = 2048;
constexpr int MP = SEQ, MS = DB * DS, M = MP + MS;
constexpr int NG = 128, NP = 64, GC = 16;
constexpr int NH = 8, HD = 128, AW = 2048;
constexpr float EPS = 1e-6f;
constexpr float LAMBDA_INIT = 0.35550906759096995f;
constexpr float QSCALE = 0.08838834764831845f * 1.4426950408889634f;
constexpr int NSSQ = 32;

constexpr size_t O_YP = 0, O_YS = O_YP + (size_t)MP * DM, O_REP = O_YS + (size_t)MS * DM, O_IMP = O_REP + NG * NP,
                 O_KP = O_IMP + NG * NP, O_VP = O_KP + (size_t)MP * AW, O_RES = O_VP + (size_t)MP * AW, O_IMS = O_RES + (size_t)DB * NG * NP,
                 O_KS = O_IMS + (size_t)DB * NG * NP, O_VS = O_KS + (size_t)MS * AW, O_END = O_VS + (size_t)MS * AW;

constexpr size_t MiB = 1u << 20;
constexpr size_t WS_CTL = 0, CTL_ZERO_BYTES = 1 * MiB;
constexpr size_t WS_SMALL = 1 * MiB;
constexpr size_t SM_ABAR = 0;
constexpr size_t SM_BB = SM_ABAR + 2 * NG * NP * 4;
constexpr size_t SM_LAM = SM_BB + 2 * (size_t)NG * NP * GC * 4;
constexpr size_t SM_END = SM_LAM + 64;
static_assert(SM_END <= 2 * MiB, "small tables");
constexpr size_t WS_SSQ1 = 3 * MiB;
constexpr size_t WS_SSQ2 = 5 * MiB;
constexpr size_t WS_RS0 = 7 * MiB;
constexpr size_t WS_ROPE = 8 * MiB;
constexpr size_t WS_WT1 = 12 * MiB;
constexpr size_t WS_WTG = 28 * MiB;
constexpr size_t WS_WTO = 36 * MiB;
constexpr size_t WS_WT5 = 44 * MiB;
constexpr size_t WS_WTB = 76 * MiB;
constexpr size_t ACT = (size_t)M * DM * 2;
constexpr size_t WS_XB = 84 * MiB;
constexpr size_t WS_UB = WS_XB + 36 * MiB, WS_SZ = WS_UB + 36 * MiB, WS_YG = WS_SZ + 36 * MiB, WS_OB = WS_YG + 36 * MiB,
                 WS_X1B = WS_OB + 36 * MiB, WS_KB = WS_X1B + 36 * MiB, WS_VB = WS_KB + 36 * MiB, WS_QB = WS_VB + 36 * MiB,
                 WS_SZ2 = WS_QB + 36 * MiB, WS_AB = WS_SZ2 + 36 * MiB;
constexpr size_t WS_X1 = WS_AB + 36 * MiB;
constexpr size_t WS_X2 = WS_X1 + 72 * MiB;
constexpr size_t WS_END = WS_X2 + 72 * MiB;
static_assert(ACT <= 36 * MiB, "act");
constexpr int CW_TMO = 0, CW_CODE = 1;
constexpr int CW_BAR = 4096;

typedef unsigned short bf16_t;
typedef short bf16x8 __attribute__((ext_vector_type(8)));
typedef float f32x4 __attribute__((ext_vector_type(4)));
typedef unsigned u32x4 __attribute__((ext_vector_type(4)));
typedef unsigned u32x2 __attribute__((ext_vector_type(2)));

__device__ __forceinline__ unsigned f2bf(float f) { unsigned u = __builtin_bit_cast(unsigned, f); return (u + 0x7fffu + ((u >> 16) & 1u)) >> 16; }
__device__ __forceinline__ unsigned pk2(float lo, float hi) { return f2bf(lo) | (f2bf(hi) << 16); }
__device__ __forceinline__ float bf2f(unsigned short b) { return __builtin_bit_cast(float, (unsigned)b << 16); }
__device__ __forceinline__ float bflo(unsigned w) { return __builtin_bit_cast(float, w << 16); }
__device__ __forceinline__ float bfhi(unsigned w) { return __builtin_bit_cast(float, w & 0xffff0000u); }
__device__ __forceinline__ float wave_sum(float v) {
#pragma unroll
    for (int o = 1; o < 64; o <<= 1) v += __shfl_xor(v, o);
    return v;
}
__device__ __forceinline__ float wave_max(float v) {
#pragma unroll
    for (int o = 1; o < 64; o <<= 1) v = fmaxf(v, __shfl_xor(v, o));
    return v;
}
__device__ __forceinline__ float sigmoid_fast(float z) { return __builtin_amdgcn_rcpf(1.f + __builtin_amdgcn_exp2f(-1.4426950408889634f * z)); }
__device__ __forceinline__ float silu_fast(float z) { return z * sigmoid_fast(z); }
__device__ __forceinline__ float gelu_tanh_f(float x) { const float t = 0.7978845608028654f * (x + 0.044715f * x * x * x); return 0.5f * x * (1.f + tanhf(t)); }
__host__ __device__ __forceinline__ int wt5_row(int n) { const int tile = n >> 8, w = n & 255, blk = w >> 7, i = w & 127; return tile * 256 + (i >> 6) * 128 + blk * 64 + (i & 63); }
namespace pg8 {
#define PG8_LAS __attribute__((address_space(3)))
typedef unsigned short bf16_t;
typedef short bf16x8 __attribute__((ext_vector_type(8)));
typedef float f32x4 __attribute__((ext_vector_type(4)));
typedef unsigned u32x4 __attribute__((ext_vector_type(4)));
constexpr int BM = 256, BK = 64, HALF = 128, HTB = HALF * BK * 2  , STAGE_BYTES = 8 * HTB, NXCD = 8, WGM = 8;

__host__ __device__ __forceinline__ int lds_byte(int r, int c) { const int st = (r >> 4) * 2 + (c >> 5), rr = r & 15, cc = c & 31, ob = rr * 64 + cc * 2; return st * 1024 + (ob ^ (((ob >> 9) & 1) << 5)); }
__host__ __device__ __forceinline__ void stage_rc(int b, int& R, int& C) { const int st = b / 1024, sb = b % 1024, swz = sb ^ (((sb >> 9) & 1) << 5); R = (st >> 1) * 16 + swz / 64; C = (st & 1) * 32 + (swz % 64) / 2; }
__host__ __device__ __forceinline__ int perm32(int rho) { const int n = rho >> 4, i = rho & 15; return 8 * (i >> 2) + 4 * n + (i & 3); }

struct Unit { int pm, pn; };
struct Gemm { const bf16_t* A; const bf16_t* Bt; int M, N, K; };

struct StaticOrder {
    int nM, nN, nwg, G, c;
    __host__ __device__ void init(int M, int N, int G_, int c_) { nM = M / BM; nN = N / BM; nwg = nM * nN; G = G_; c = c_; }
    __host__ __device__ bool next(int i, Unit& u) const {
        const long L = (long)i * G + c; if (L >= nwg) return false;
        int wgid = (int)L; { const int q = nwg / NXCD, r = nwg % NXCD, xcd = wgid % NXCD, off = wgid / NXCD; wgid = (xcd < r ? xcd * (q + 1) : r * (q + 1) + (xcd - r) * q) + off; }
        const int nig = WGM * nN, gid = wgid / nig, fm = gid * WGM, gsz = (nM - fm) < WGM ? (nM - fm) : WGM;
        u.pm = fm + ((wgid % nig) % gsz); u.pn = (wgid % nig) / gsz; return true;
    }
    __device__ __forceinline__ void a_ready(const Unit&) const {}
    __device__ __forceinline__ void done(const Unit&) const {}
};

__device__ __forceinline__ unsigned cvt_pk_bf16(float lo, float hi) { unsigned r; asm volatile("v_cvt_pk_bf16_f32 %0, %1, %2" : "=v"(r) : "v"(lo), "v"(hi)); return r; }
__device__ __forceinline__ float sigm(float z) { return __builtin_amdgcn_rcpf(1.f + __builtin_amdgcn_exp2f(-1.4426950408889634f * z)); }
__device__ __forceinline__ u32x4 pack8(const f32x4& a, const f32x4& b) { u32x4 w; w.x = cvt_pk_bf16(a[0], a[1]); w.y = cvt_pk_bf16(a[2], a[3]); w.z = cvt_pk_bf16(b[0], b[1]); w.w = cvt_pk_bf16(b[2], b[3]); return w; }
__device__ __forceinline__ f32x4 unlo(const u32x4& w) { return (f32x4){__builtin_bit_cast(float, w.x << 16), __builtin_bit_cast(float, w.x & 0xffff0000u), __builtin_bit_cast(float, w.y << 16), __builtin_bit_cast(float, w.y & 0xffff0000u)}; }
__device__ __forceinline__ f32x4 unhi(const u32x4& w) { return (f32x4){__builtin_bit_cast(float, w.z << 16), __builtin_bit_cast(float, w.z & 0xffff0000u), __builtin_bit_cast(float, w.w << 16), __builtin_bit_cast(float, w.w & 0xffff0000u)}; }
__device__ __forceinline__ f32x4 silu4(const f32x4& v) { return (f32x4){v[0] * sigm(v[0]), v[1] * sigm(v[1]), v[2] * sigm(v[2]), v[3] * sigm(v[3])}; }
__device__ __forceinline__ f32x4 sigm4(const f32x4& v) { return (f32x4){sigm(v[0]), sigm(v[1]), sigm(v[2]), sigm(v[3])}; }

struct EpiUZ {
    static constexpr bool PERM = true, AFTER_DRAIN = false;
    bf16_t* Ub; bf16_t* SZ; const float* rs;
    __device__ __forceinline__ void operator()(const f32x4 (&acc)[2][2][4][2], const Unit& u, int wr, int wc, int fr, int fq) const {
        const int row0 = u.pm * BM + wr * 64 + fr; const bool isz = u.pn >= 8; bf16_t* base = isz ? SZ : Ub; const int col0 = (u.pn & 7) * BM + wc * 32 + 8 * fq;
#pragma unroll
        for (int ai = 0; ai < 2; ++ai)
#pragma unroll
            for (int m = 0; m < 4; ++m) { const int row = row0 + ai * HALF + m * 16; const float s = rs[row]; bf16_t* rowp = base + (size_t)row * 2048 + col0;
#pragma unroll
                for (int bj = 0; bj < 2; ++bj) { f32x4 v0 = acc[ai][bj][m][0] * s, v1 = acc[ai][bj][m][1] * s;
                    if (isz) { v0 = silu4(v0); v1 = silu4(v1); }
                    *(u32x4*)(rowp + bj * HALF) = pack8(v0, v1); } }
    }
};
struct EpiGlu {
    static constexpr bool PERM = true, AFTER_DRAIN = false;
    const bf16_t* Yg; const bf16_t* SZ; bf16_t* Ob;
    __device__ __forceinline__ void operator()(const f32x4 (&acc)[2][2][4][2], const Unit& u, int wr, int wc, int fr, int fq) const {
        const int row0 = u.pm * BM + wr * 64 + fr; const int col0 = u.pn * BM + wc * 32 + 8 * fq;
#pragma unroll
        for (int ai = 0; ai < 2; ++ai)
#pragma unroll
            for (int m = 0; m < 4; ++m) { const size_t off = (size_t)(row0 + ai * HALF + m * 16) * 2048 + col0;
#pragma unroll
                for (int bj = 0; bj < 2; ++bj) { const u32x4 y = *(const u32x4*)(Yg + off + bj * HALF), z = *(const u32x4*)(SZ + off + bj * HALF);
                    const f32x4 v0 = unlo(y) * sigm4(acc[ai][bj][m][0]) * unlo(z), v1 = unhi(y) * sigm4(acc[ai][bj][m][1]) * unhi(z);
                    *(u32x4*)(Ob + off + bj * HALF) = pack8(v0, v1); } }
    }
};
struct EpiRes {
    static constexpr bool PERM = true, AFTER_DRAIN = false;
    const float* base_p; const float* base_s; float* X; bf16_t* Xb; float* ssq;
    __device__ __forceinline__ void operator()(const f32x4 (&acc)[2][2][4][2], const Unit& u, int wr, int wc, int fr, int fq) const {
        const int row0 = u.pm * BM + wr * 64 + fr; const int col0 = u.pn * BM + wc * 32 + 8 * fq;
        const bool prm = u.pm < MP / BM; const float* bs = prm ? base_p : base_s; const size_t bsub = prm ? 0 : (size_t)MP * 2048;
#pragma unroll
        for (int ai = 0; ai < 2; ++ai)
#pragma unroll
            for (int m = 0; m < 4; ++m) { const int row = row0 + ai * HALF + m * 16; const size_t off = (size_t)row * 2048 + col0; float q = 0.f;
#pragma unroll
                for (int bj = 0; bj < 2; ++bj) { const f32x4 b0 = *(const f32x4*)(bs + (off - bsub) + bj * HALF), b1 = *(const f32x4*)(bs + (off - bsub) + bj * HALF + 4);
                    const f32x4 v0 = b0 + acc[ai][bj][m][0], v1 = b1 + acc[ai][bj][m][1];
                    *(f32x4*)(X + off + bj * HALF) = v0; *(f32x4*)(X + off + bj * HALF + 4) = v1;
                    q += (v0[0] * v0[0] + v0[1] * v0[1]) + (v0[2] * v0[2] + v0[3] * v0[3]) + (v1[0] * v1[0] + v1[1] * v1[1]) + (v1[2] * v1[2] + v1[3] * v1[3]);
                    if (Xb) *(u32x4*)(Xb + off + bj * HALF) = pack8(v0, v1); }
                q += __shfl_xor(q, 16); q += __shfl_xor(q, 32);
                if (fq == 0) ssq[(size_t)row * NSSQ + u.pn * 4 + wc] = q; }
    }
};
struct EpiKVQZ {
    static constexpr bool PERM = true, AFTER_DRAIN = false;
    const float* ssq; const float* rope; float* out; bf16_t* Kb; bf16_t* Vb; bf16_t* Qb; bf16_t* SZ2;
    __device__ __forceinline__ void operator()(const f32x4 (&acc)[2][2][4][2], const Unit& u, int wr, int wc, int fr, int fq) const {
        const int row0 = u.pm * BM + wr * 64 + fr; const int kind = u.pn >> 3; const int f0 = 32 * (wc & 1) + 8 * fq;
        const int lcol = (u.pn & 7) * BM + (wc >> 1) * 128 + f0;
        const bool prm = u.pm < MP / BM;
        float* ko = prm ? out + O_KP : out + O_KS; float* vo = prm ? out + O_VP : out + O_VS; const size_t osub = prm ? 0 : (size_t)MP * 2048;
#pragma unroll
        for (int ai = 0; ai < 2; ++ai)
#pragma unroll
            for (int m = 0; m < 4; ++m) { const int row = row0 + ai * HALF + m * 16; const size_t off = (size_t)row * 2048 + lcol;
                const f32x4 p0 = *(const f32x4*)(ssq + (size_t)row * NSSQ + 8 * fq), p1 = *(const f32x4*)(ssq + (size_t)row * NSSQ + 8 * fq + 4);
                float q = (p0[0] + p0[1]) + (p0[2] + p0[3]) + (p1[0] + p1[1]) + (p1[2] + p1[3]); q += __shfl_xor(q, 16); q += __shfl_xor(q, 32);
                const float rs = 1.0f / sqrtf(q * (1.0f / 2048.0f) + EPS);
                f32x4 a0 = acc[ai][0][m][0] * rs, a1 = acc[ai][0][m][1] * rs, b0 = acc[ai][1][m][0] * rs, b1 = acc[ai][1][m][1] * rs;
                if (kind == 0 || kind == 2) {
                    const int pos = prm ? row : PAST + ((row - MP) & 15);
                    const float* cp = rope + (size_t)pos * 64 + f0; const float* sp = cp + (size_t)SEQ * 64;
                    const f32x4 c0 = *(const f32x4*)cp, c1 = *(const f32x4*)(cp + 4), s0 = *(const f32x4*)sp, s1 = *(const f32x4*)(sp + 4);
                    const f32x4 y0 = a0 * c0 - b0 * s0, y1 = a1 * c1 - b1 * s1, z0 = a0 * s0 + b0 * c0, z1 = a1 * s1 + b1 * c1;
                    a0 = y0; a1 = y1; b0 = z0; b1 = z1;
                }
                if (kind == 0) { { float* o = ko + (off - osub); *(f32x4*)(o) = a0; *(f32x4*)(o + 4) = a1; *(f32x4*)(o + 64) = b0; *(f32x4*)(o + 68) = b1; }
                    *(u32x4*)(Kb + off) = pack8(a0, a1); *(u32x4*)(Kb + off + 64) = pack8(b0, b1); }
                else if (kind == 1) { { float* o = vo + (off - osub); *(f32x4*)(o) = a0; *(f32x4*)(o + 4) = a1; *(f32x4*)(o + 64) = b0; *(f32x4*)(o + 68) = b1; }
                    *(u32x4*)(Vb + off) = pack8(a0, a1); *(u32x4*)(Vb + off + 64) = pack8(b0, b1); }
                else if (kind == 2) { *(u32x4*)(Qb + off) = pack8(a0 * QSCALE, a1 * QSCALE); *(u32x4*)(Qb + off + 64) = pack8(b0 * QSCALE, b1 * QSCALE); }
                else { *(u32x4*)(SZ2 + off) = pack8(silu4(a0), silu4(a1)); *(u32x4*)(SZ2 + off + 64) = pack8(silu4(b0), silu4(b1)); } }
    }
};
template <class Epi, class Sched, bool ALIGN_EPI = false, bool SP2 = false>
__device__ __forceinline__ void gemm_phase(PG8_LAS unsigned char* lds, const Gemm g, const Sched& S, const Epi& E) {
    const int tid = threadIdx.x, wid = __builtin_amdgcn_readfirstlane(tid >> 6), lane = tid & 63, wr = wid >> 2, wc = wid & 3, fr = lane & 15, fq = lane >> 4;
    const int K = g.K, nt = K / BK;
    unsigned voffA[2], voffB[2];
#pragma unroll
    for (int i = 0; i < 2; ++i) { int R, C; stage_rc(tid * 16 + i * 8192, R, C); const int Rb = Epi::PERM ? ((R & ~31) + perm32(R & 31)) : R;
        voffA[i] = (unsigned)(R * K + C) * 2u; voffB[i] = (unsigned)(Rb * K + C) * 2u; }
    const size_t kstep = (size_t)(BK * 2);
    const size_t hstep = (size_t)HALF * K * 2;
    const size_t tstep = 2 * hstep;
    const unsigned ldsw = (unsigned)wid * 1024u;
    const int aoff = lds_byte(wr * 64 + fr, fq * 8), boff = lds_byte(wc * 32 + fr, fq * 8);
#define PG8_SA(b, h) (((b) * 2 + (h)) * HTB)
#define PG8_SB(b, h) ((4 + (b) * 2 + (h)) * HTB)
#define PG8_STAGE(bufoff, gbase, voff) do { _Pragma("unroll") for (int _i = 0; _i < 2; ++_i) \
        __builtin_amdgcn_global_load_lds((const unsigned*)((const char*)(gbase) + (voff)[_i]), (PG8_LAS unsigned*)(lds + (bufoff) + ldsw + _i * 8192), 16, 0, 0); } while (0)
#define PG8_LDA(dst, b, h) do { _Pragma("unroll") for (int m = 0; m < 4; ++m) _Pragma("unroll") for (int k = 0; k < 2; ++k) dst[m][k] = *(const PG8_LAS bf16x8*)(lds + PG8_SA(b, h) + aoff + m * 2048 + k * 1024); } while (0)
#define PG8_LDB(dst, b, h) do { _Pragma("unroll") for (int n = 0; n < 2; ++n) _Pragma("unroll") for (int k = 0; k < 2; ++k) dst[n][k] = *(const PG8_LAS bf16x8*)(lds + PG8_SB(b, h) + boff + n * 2048 + k * 1024); } while (0)
#define PG8_MMA(ai, bj, At, Bt) do { __builtin_amdgcn_s_setprio(1); _Pragma("unroll") for (int m = 0; m < 4; ++m) _Pragma("unroll") for (int n = 0; n < 2; ++n) _Pragma("unroll") for (int k = 0; k < 2; ++k) \
        acc[ai][bj][m][n] = __builtin_amdgcn_mfma_f32_16x16x32_bf16(Bt[n][k], At[m][k], acc[ai][bj][m][n], 0, 0, 0); __builtin_amdgcn_s_setprio(0); } while (0)
#define PG8_WAIT_V(n) asm volatile("s_waitcnt vmcnt(" #n ")" ::: "memory")
#define PG8_WAIT_L(n) asm volatile("s_waitcnt lgkmcnt(" #n ")" ::: "memory")
#define PG8_BAR __builtin_amdgcn_s_barrier()
#define PG8_SCHED __builtin_amdgcn_sched_barrier(0)
    Unit cur, nxt; int ui = 0;
    if (!S.next(0, cur)) return;
    f32x4 acc[2][2][4][2];
#pragma unroll
    for (int a = 0; a < 2; ++a)
#pragma unroll
        for (int b = 0; b < 2; ++b)
#pragma unroll
            for (int m = 0; m < 4; ++m)
#pragma unroll
                for (int n = 0; n < 2; ++n) acc[a][b][m][n] = (f32x4){0.f, 0.f, 0.f, 0.f};
    bf16x8 At[4][2], B0[2][2], B1[2][2];
    const char* cA = (const char*)g.A + (size_t)cur.pm * tstep; const char* cB = (const char*)g.Bt + (size_t)cur.pn * tstep;
    S.a_ready(cur);
    if constexpr (SP2) {
        PG8_STAGE(PG8_SB(0, 0), cB, voffB); PG8_STAGE(PG8_SB(0, 1), cB + hstep, voffB); PG8_STAGE(PG8_SA(0, 0), cA, voffA); PG8_STAGE(PG8_SA(0, 1), cA + hstep, voffA);
        if (wr == 1) PG8_BAR;
        PG8_WAIT_V(2); PG8_BAR;
        PG8_STAGE(PG8_SB(1, 0), cB + kstep, voffB); PG8_STAGE(PG8_SA(1, 0), cA + kstep, voffA); PG8_STAGE(PG8_SB(1, 1), cB + hstep + kstep, voffB);
        PG8_WAIT_V(6); PG8_BAR;
    } else {
        PG8_STAGE(PG8_SB(0, 0), cB, voffB); PG8_STAGE(PG8_SA(0, 0), cA, voffA); PG8_STAGE(PG8_SB(0, 1), cB + hstep, voffB); PG8_STAGE(PG8_SA(0, 1), cA + hstep, voffA);
        if (wr == 1) PG8_BAR;
        PG8_WAIT_V(4); PG8_BAR;
        PG8_STAGE(PG8_SB(1, 0), cB + kstep, voffB); PG8_STAGE(PG8_SA(1, 0), cA + kstep, voffA); PG8_STAGE(PG8_SB(1, 1), cB + hstep + kstep, voffB);
        PG8_WAIT_V(6); PG8_BAR;
    }
    for (;;) {
        const bool has_next = S.next(ui + 1, nxt);
        const char* nA = has_next ? (const char*)g.A + (size_t)nxt.pm * tstep : cA; const char* nB = has_next ? (const char*)g.Bt + (size_t)nxt.pn * tstep : cB;
        for (int t = 0; t < nt; t += 2) {
            const bool last = (t == nt - 2);
            const char* a1 = cA + (size_t)(t + 1) * kstep;
            const char* a2 = last ? nA : cA + (size_t)(t + 2) * kstep; const char* b2 = last ? nB : cB + (size_t)(t + 2) * kstep;
            const char* a3 = a2 + kstep; const char* b3 = b2 + kstep;
            if (last && has_next) S.a_ready(nxt);
            if constexpr (SP2) {
            PG8_LDB(B0, 0, 0); PG8_LDB(B1, 0, 1); PG8_SCHED; PG8_LDA(At, 0, 0); PG8_STAGE(PG8_SA(1, 1), a1 + hstep, voffA);
            PG8_WAIT_V(8); PG8_WAIT_L(0); PG8_BAR; PG8_MMA(0, 0, At, B0); PG8_MMA(0, 1, At, B1); PG8_BAR; PG8_SCHED;
            PG8_LDA(At, 0, 1); PG8_STAGE(PG8_SB(0, 0), b2, voffB); PG8_STAGE(PG8_SB(0, 1), b2 + hstep, voffB); PG8_STAGE(PG8_SA(0, 0), a2, voffA);
            PG8_WAIT_V(8); PG8_WAIT_L(0); PG8_BAR; PG8_MMA(1, 0, At, B0); PG8_MMA(1, 1, At, B1); PG8_BAR; PG8_SCHED;
            PG8_LDB(B0, 1, 0); PG8_LDB(B1, 1, 1); PG8_SCHED; PG8_LDA(At, 1, 0); PG8_STAGE(PG8_SA(0, 1), a2 + hstep, voffA);
            PG8_WAIT_V(8); PG8_WAIT_L(0); PG8_BAR; PG8_MMA(0, 0, At, B0); PG8_MMA(0, 1, At, B1); PG8_BAR; PG8_SCHED;
            PG8_LDA(At, 1, 1); PG8_STAGE(PG8_SB(1, 0), b3, voffB); PG8_STAGE(PG8_SB(1, 1), b3 + hstep, voffB); PG8_STAGE(PG8_SA(1, 0), a3, voffA);
            PG8_WAIT_V(8); PG8_WAIT_L(0); PG8_BAR; PG8_MMA(1, 0, At, B0); PG8_MMA(1, 1, At, B1); PG8_BAR; PG8_SCHED;
            } else {
            PG8_LDB(B0, 0, 0); PG8_SCHED; PG8_LDA(At, 0, 0); PG8_STAGE(PG8_SA(1, 1), a1 + hstep, voffA);
            PG8_WAIT_L(8); PG8_BAR; PG8_WAIT_L(0); PG8_MMA(0, 0, At, B0); PG8_BAR; PG8_SCHED;
            PG8_LDB(B1, 0, 1); PG8_STAGE(PG8_SB(0, 0), b2, voffB);
            PG8_BAR; PG8_WAIT_L(0); PG8_MMA(0, 1, At, B1); PG8_BAR;
            PG8_LDA(At, 0, 1); PG8_STAGE(PG8_SA(0, 0), a2, voffA);
            PG8_BAR; PG8_WAIT_L(0); PG8_MMA(1, 0, At, B0); PG8_BAR; PG8_SCHED;
            PG8_STAGE(PG8_SB(0, 1), b2 + hstep, voffB);
            PG8_WAIT_V(6); PG8_BAR; PG8_MMA(1, 1, At, B1); PG8_BAR;
            PG8_LDB(B0, 1, 0); PG8_SCHED; PG8_LDA(At, 1, 0); PG8_STAGE(PG8_SA(0, 1), a2 + hstep, voffA);
            PG8_WAIT_L(8); PG8_BAR; PG8_WAIT_L(0); PG8_MMA(0, 0, At, B0); PG8_BAR; PG8_SCHED;
            PG8_LDB(B1, 1, 1); PG8_STAGE(PG8_SB(1, 0), b3, voffB);
            PG8_BAR; PG8_WAIT_L(0); PG8_MMA(0, 1, At, B1); PG8_BAR;
            PG8_LDA(At, 1, 1); PG8_STAGE(PG8_SA(1, 0), a3, voffA);
            PG8_BAR; PG8_WAIT_L(0); PG8_MMA(1, 0, At, B0); PG8_BAR; PG8_SCHED;
            PG8_STAGE(PG8_SB(1, 1), b3 + hstep, voffB);
            PG8_WAIT_V(6); PG8_BAR; PG8_MMA(1, 1, At, B1); PG8_BAR;
            }
        }
        if constexpr (ALIGN_EPI) { if (wr == 0) PG8_BAR; }
        if constexpr (!Epi::AFTER_DRAIN) { E(acc, cur, wr, wc, fr, fq); S.done(cur); }
        if (!has_next) break;
#pragma unroll
        for (int a = 0; a < 2; ++a)
#pragma unroll
            for (int b = 0; b < 2; ++b)
#pragma unroll
                for (int m = 0; m < 4; ++m)
#pragma unroll
                    for (int n = 0; n < 2; ++n) acc[a][b][m][n] = (f32x4){0.f, 0.f, 0.f, 0.f};
        cur = nxt; cA = nA; cB = nB; ++ui;
        if constexpr (ALIGN_EPI) { if (wr == 1) PG8_BAR; }
    }
    PG8_WAIT_V(0);
    if constexpr (!ALIGN_EPI) { if (wr == 0) PG8_BAR; }
    PG8_BAR;
    if constexpr (Epi::AFTER_DRAIN) { E.fused(acc, cur, wr, wc, fr, fq, lds, wid, lane); S.done(cur); }
#undef PG8_SA
#undef PG8_SB
#undef PG8_STAGE
#undef PG8_LDA
#undef PG8_LDB
#undef PG8_MMA
#undef PG8_WAIT_V
#undef PG8_WAIT_L
#undef PG8_BAR
#undef PG8_SCHED
}
}

namespace sk {
using pg8::bf16_t; using pg8::bf16x8; using pg8::f32x4; using pg8::u32x4;
typedef unsigned u32x2 __attribute__((ext_vector_type(2)));
__device__ __forceinline__ u32x2 pack4(const f32x4& a) { u32x2 w; w.x = pg8::cvt_pk_bf16(a[0], a[1]); w.y = pg8::cvt_pk_bf16(a[2], a[3]); return w; }
__device__ __forceinline__ f32x4 un4(const u32x2& w) { return (f32x4){__builtin_bit_cast(float, w.x << 16), __builtin_bit_cast(float, w.x & 0xffff0000u), __builtin_bit_cast(float, w.y << 16), __builtin_bit_cast(float, w.y & 0xffff0000u)}; }
struct EpiUZ { bf16_t* Ub; bf16_t* SZ; const float* rs;
    __device__ __forceinline__ void operator()(int row, int ct, int w, int fq, f32x4 v0, f32x4 v1) const {
        const float s = rs[row]; const bool isz = ct >= 8; bf16_t* p = (isz ? SZ : Ub) + (size_t)row * 2048 + (ct & 7) * 256 + 16 * w + 4 * fq;
        v0 = v0 * s; v1 = v1 * s; if (isz) { v0 = pg8::silu4(v0); v1 = pg8::silu4(v1); }
        *(u32x2*)p = pack4(v0); *(u32x2*)(p + 128) = pack4(v1); } };
struct EpiGlu { const bf16_t* Yg; const bf16_t* SZ; bf16_t* Ob;
    __device__ __forceinline__ void operator()(int row, int ct, int w, int fq, f32x4 v0, f32x4 v1) const {
        const size_t off = (size_t)row * 2048 + ct * 256 + 16 * w + 4 * fq;
        const u32x2 y0 = *(const u32x2*)(Yg + off), y1 = *(const u32x2*)(Yg + off + 128), z0 = *(const u32x2*)(SZ + off), z1 = *(const u32x2*)(SZ + off + 128);
        *(u32x2*)(Ob + off) = pack4(un4(y0) * pg8::sigm4(v0) * un4(z0)); *(u32x2*)(Ob + off + 128) = pack4(un4(y1) * pg8::sigm4(v1) * un4(z1)); } };
struct EpiRes { const float* base; float* X; bf16_t* Xb; float* ssq;
    __device__ __forceinline__ void operator()(int row, int ct, int w, int fq, f32x4 v0, f32x4 v1) const {
        const size_t off = (size_t)row * 2048 + ct * 256 + 16 * w + 4 * fq;
        v0 += *(const f32x4*)(base + off); v1 += *(const f32x4*)(base + off + 128);
        *(f32x4*)(X + off) = v0; *(f32x4*)(X + off + 128) = v1;
        if (Xb) { *(u32x2*)(Xb + off) = pack4(v0); *(u32x2*)(Xb + off + 128) = pack4(v1); }
        float q = (v0[0] * v0[0] + v0[1] * v0[1]) + (v0[2] * v0[2] + v0[3] * v0[3]) + (v1[0] * v1[0] + v1[1] * v1[1]) + (v1[2] * v1[2] + v1[3] * v1[3]);
        q += __shfl_xor(q, 16); q += __shfl_xor(q, 32);
        if (fq == 0) atomicAdd(ssq + (size_t)row * NSSQ + ct * 4 + (w >> 1), q); } };
struct EpiKVQZ { const float* ssq; const float* rope; float* out; bf16_t* Kb; bf16_t* Vb; bf16_t* Qb; bf16_t* SZ2;
    __device__ __forceinline__ void operator()(int row, int ct, int w, int fq, f32x4 a, f32x4 b) const {
        const int kind = ct >> 3, f0 = 16 * (w & 3) + 4 * fq; const size_t off = (size_t)row * 2048 + (ct & 7) * 256 + (w >> 2) * 128 + f0;
        const f32x4 p0 = *(const f32x4*)(ssq + (size_t)row * NSSQ + 8 * fq), p1 = *(const f32x4*)(ssq + (size_t)row * NSSQ + 8 * fq + 4);
        float q = (p0[0] + p0[1]) + (p0[2] + p0[3]) + (p1[0] + p1[1]) + (p1[2] + p1[3]); q += __shfl_xor(q, 16); q += __shfl_xor(q, 32);
        const float rs = 1.0f / sqrtf(q * (1.0f / 2048.0f) + EPS);
        a = a * rs; b = b * rs;
        if (kind == 0 || kind == 2) { const int pos = PAST + ((row - MP) & 15); const float* cp = rope + (size_t)pos * 64 + f0;
            const f32x4 c = *(const f32x4*)cp, s = *(const f32x4*)(cp + (size_t)SEQ * 64); const f32x4 y = a * c - b * s, z = a * s + b * c; a = y; b = z; }
        const size_t oo = off - (size_t)MP * 2048;
        if (kind == 0) { *(f32x4*)(out + O_KS + oo) = a; *(f32x4*)(out + O_KS + oo + 64) = b; *(u32x2*)(Kb + off) = pack4(a); *(u32x2*)(Kb + off + 64) = pack4(b); }
        else if (kind == 1) { *(f32x4*)(out + O_VS + oo) = a; *(f32x4*)(out + O_VS + oo + 64) = b; *(u32x2*)(Vb + off) = pack4(a); *(u32x2*)(Vb + off + 64) = pack4(b); }
        else if (kind == 2) { *(u32x2*)(Qb + off) = pack4(a * QSCALE); *(u32x2*)(Qb + off + 64) = pack4(b * QSCALE); }
        else { *(u32x2*)(SZ2 + off) = pack4(pg8::silu4(a)); *(u32x2*)(SZ2 + off + 64) = pack4(pg8::silu4(b)); } } };
template <int N_> __device__ __forceinline__ void sk_wait() {
#define SK_W(n) else if constexpr (N_ == n) asm volatile("s_waitcnt vmcnt(" #n ")" ::: "memory");
    if constexpr (N_ == 0) asm volatile("s_waitcnt vmcnt(0)" ::: "memory");
    SK_W(2) SK_W(3) SK_W(4) SK_W(6) SK_W(8)
    else static_assert(N_ == 0, "sk_wait: add the count");
#undef SK_W
}
template <int RBK, int CW, class Epi> __device__ __forceinline__ void phase(PG8_LAS unsigned char* lds, const bf16_t* A, const bf16_t* Bt, int N, const Epi& E, int vcu, int nwg) {
    constexpr int K = 2048, NT = K / 64, NCB = CW / 16, RBW = RBK * NCB / 8, NCQ = 128 / CW, NRG = DB / RBK;
    constexpr int NBP = 2 * CW / 8, NAP = 16 * RBK / 8, P = (NBP + NAP) / 8, A_OFF = NBP * 1024, SLOT = (NBP + NAP) * 1024, NS = 4;
    static_assert((NBP + NAP) % 8 == 0 && RBW >= 1 && NS * SLOT <= 131072, "skinny item shape");
    const int tid = threadIdx.x, w = __builtin_amdgcn_readfirstlane(tid >> 6), lane = tid & 63, fr = lane & 15, fq = lane >> 4;
    const int nitems = NRG * (N / 256) * NCQ, cbp = w % NCB, rsub = w / NCB;
    const int rd0 = fr * 128 + ((fq ^ (fr & 7)) * 16), rd1 = fr * 128 + (((4 + fq) ^ (fr & 7)) * 16);
    for (int it = vcu; it < nitems; it += nwg) {
        const int rg = it % NRG, ccol = it / NRG, ct = ccol / NCQ, cq = ccol % NCQ, r0 = MP + 16 * RBK * rg;
        const char* src[P]; unsigned dst[P];
#pragma unroll
        for (int j = 0; j < P; ++j) { const int gp = w * P + j; const bool isb = gp < NBP; const int p = isb ? gp : gp - NBP, row = 8 * p + (lane >> 3), cl = (lane & 7) ^ (row & 7);
            const size_t grow = isb ? (size_t)(ct * 256 + (row < CW ? cq * CW + row : 128 + cq * CW + (row - CW))) : (size_t)(r0 + row);
            src[j] = (const char*)((isb ? Bt : A) + grow * K) + cl * 16; dst[j] = (unsigned)((isb ? 0 : A_OFF) + p * 1024); }
#define SK_STAGE(s, t) do { _Pragma("unroll") for (int j_ = 0; j_ < P; ++j_) \
            __builtin_amdgcn_global_load_lds((const unsigned*)(src[j_] + (size_t)(t) * 128), (PG8_LAS unsigned*)(lds + (s) * SLOT + __builtin_amdgcn_readfirstlane((int)dst[j_])), 16, 0, 0); } while (0)
        f32x4 acc[RBW][2];
#pragma unroll
        for (int i = 0; i < RBW; ++i) { acc[i][0] = (f32x4){0.f, 0.f, 0.f, 0.f}; acc[i][1] = (f32x4){0.f, 0.f, 0.f, 0.f}; }
        SK_STAGE(0, 0); SK_STAGE(1, 1); SK_STAGE(2, 2);
        for (int t4 = 0; t4 < NT / 4; ++t4) {
#define SK_STEP(u) do { const int t = 4 * t4 + (u); \
            if (t + 2 < NT) sk_wait<2 * P>(); else if (t + 1 < NT) sk_wait<P>(); else sk_wait<0>();       \
            asm volatile("s_waitcnt lgkmcnt(0)" ::: "memory"); __builtin_amdgcn_s_barrier(); asm volatile("" ::: "memory"); \
            if (t + 3 < NT) SK_STAGE(((u) + 3) & 3, t + 3);                                              \
            bf16x8 af[RBW][2]; \
            _Pragma("unroll") for (int i_ = 0; i_ < RBW; ++i_) { const int ab_ = (u) * SLOT + A_OFF + (rsub * RBW + i_) * 2048; af[i_][0] = *(const PG8_LAS bf16x8*)(lds + ab_ + rd0); af[i_][1] = *(const PG8_LAS bf16x8*)(lds + ab_ + rd1); } \
            _Pragma("unroll") for (int h_ = 0; h_ < 2; ++h_) { const int bb_ = (u) * SLOT + (h_ * CW + 16 * cbp) * 128; \
                const bf16x8 b0_ = *(const PG8_LAS bf16x8*)(lds + bb_ + rd0), b1_ = *(const PG8_LAS bf16x8*)(lds + bb_ + rd1); \
                _Pragma("unroll") for (int i_ = 0; i_ < RBW; ++i_) { acc[i_][h_] = __builtin_amdgcn_mfma_f32_16x16x32_bf16(b0_, af[i_][0], acc[i_][h_], 0, 0, 0); \
                    acc[i_][h_] = __builtin_amdgcn_mfma_f32_16x16x32_bf16(b1_, af[i_][1], acc[i_][h_], 0, 0, 0); } } } while (0)
            SK_STEP(0); SK_STEP(1); SK_STEP(2); SK_STEP(3);
#undef SK_STEP
        }
        asm volatile("s_waitcnt vmcnt(0) lgkmcnt(0)" ::: "memory"); __builtin_amdgcn_s_barrier(); asm volatile("" ::: "memory");
#pragma unroll
        for (int i = 0; i < RBW; ++i) E(r0 + 16 * (rsub * RBW + i) + fr, ct, cq * NCB + cbp, fq, acc[i][0], acc[i][1]);
#undef SK_STAGE
    }
}
}

constexpr int NWAVES = 8;
constexpr int RING_OFF = 0, RING_BYTES = 131072;
constexpr int LDSCTL_OFF = RING_BYTES, MISC_OFF = LDSCTL_OFF + 320;
constexpr int LDS_BYTES = 155648;
static_assert(MISC_OFF + 128 <= LDS_BYTES, "LDS map");

#define GAS __attribute__((address_space(1)))
#define LAS __attribute__((address_space(3)))
typedef GAS unsigned gu32;
#define RLX_AGENT __ATOMIC_RELAXED, __HIP_MEMORY_SCOPE_AGENT
#define LDS_WAIT() asm volatile("s_waitcnt lgkmcnt(0)" ::: "memory")
#define VM_WAIT() asm volatile("s_waitcnt vmcnt(0)" ::: "memory")
#define XB_TMO      128
#define XB_XCNT(j)  (256  + 64 * (j))
#define XB_XSUB(j)  (1280 + 64 * (j))
#define XB_XGEN(j)  (2304 + 64 * (j))
#define XB_TOP      3328
#define XB_TOPGEN   3392
#define XCD_BAR_WORDS 3456
#define XB_SPIN_CAP (1u << 18)

__device__ __forceinline__ unsigned xb_ld(unsigned* p)              { return __hip_atomic_load(p, __ATOMIC_RELAXED, __HIP_MEMORY_SCOPE_AGENT); }
__device__ __forceinline__ unsigned xb_add(unsigned* p, unsigned v) { return __hip_atomic_fetch_add(p, v, __ATOMIC_RELAXED, __HIP_MEMORY_SCOPE_AGENT); }
__device__ __forceinline__ unsigned xb_xcc_id() { return (unsigned)__builtin_amdgcn_s_getreg((3 << 11) | 20) & 0xFu; }
#define XB_SPIN(cond, bar) do { unsigned _sp = 0; while (cond) { __builtin_amdgcn_s_sleep(1); \
    if ((++_sp & 255u) == 0u) { if (xb_ld(&(bar)[XB_TMO])) break; if (_sp > XB_SPIN_CAP) { atomicAdd(&(bar)[XB_TMO], 1u); break; } } } } while (0)

struct XcdBarrier {
    unsigned* bar; unsigned x;
    volatile LAS unsigned* st;
};

__device__ __forceinline__ XcdBarrier xcd_barrier_post(unsigned* bar, volatile LAS unsigned* st) {
    XcdBarrier b; b.bar = bar; b.x = xb_xcc_id(); b.st = st;
    if (threadIdx.x == 0) (void)xb_add(&bar[XB_XCNT(b.x)], 1u);
    return b;
}
__device__ __forceinline__ void xcd_barrier_complete(unsigned* bar, unsigned x, unsigned& nloc, unsigned& nx) {
    const unsigned G = gridDim.x * gridDim.y * gridDim.z;
    unsigned sum, cnt, mine, sp = 0u;
    for (;;) {
        sum = 0u; cnt = 0u; mine = 0u;
#pragma unroll
        for (unsigned j = 0; j < 16; ++j) { const unsigned c = xb_ld(&bar[XB_XCNT(j)]); sum += c; cnt += (c > 0u) ? 1u : 0u; mine = (j == x) ? c : mine; }
        if (sum == G) break;
        __builtin_amdgcn_s_sleep(1);
        if ((++sp & 255u) == 0u) { if (xb_ld(&bar[XB_TMO])) break; if (sp > XB_SPIN_CAP) { atomicAdd(&bar[XB_TMO], 1u); break; } }
    }
    nloc = mine > 0u ? mine : 1u; nx = cnt > 0u ? cnt : 1u;
}

__device__ __forceinline__ void xcd_barrier(const XcdBarrier& b) {
    asm volatile("s_waitcnt vmcnt(0)" ::: "memory");
    __syncthreads();
    if (threadIdx.x == 0) {
        unsigned* bar = b.bar;
        __builtin_amdgcn_s_waitcnt(0);
        unsigned nloc = b.st[0], nx = b.st[1];
        if (nloc == 0u) { xcd_barrier_complete(bar, b.x, nloc, nx); b.st[0] = nloc; b.st[1] = nx; }
        const unsigned old = xb_add(&bar[XB_XSUB(b.x)], 1u);
        const unsigned gen = old / nloc;
        if (old + 1u == (gen + 1u) * nloc) {
            __builtin_amdgcn_fence(__ATOMIC_RELEASE, "agent");
            asm volatile("s_waitcnt vmcnt(0)" ::: "memory");
            const unsigned og = xb_add(&bar[XB_TOP], 1u);
            const unsigned tg = og / nx;
            if (og + 1u == (tg + 1u) * nx) xb_add(&bar[XB_TOPGEN], 1u);
            else XB_SPIN(xb_ld(&bar[XB_TOPGEN]) == tg, bar);
            __builtin_amdgcn_fence(__ATOMIC_ACQUIRE, "agent");
            xb_add(&bar[XB_XGEN(b.x)], 1u);
            asm volatile("s_waitcnt vmcnt(0)" ::: "memory");
        } else {
            XB_SPIN(xb_ld(&bar[XB_XGEN(b.x)]) == gen, bar);
            __builtin_amdgcn_fence(__ATOMIC_ACQUIRE, "agent");
            asm volatile("s_waitcnt vmcnt(0)" ::: "memory");
        }
    }
    __syncthreads();
}

struct Frame {
    LAS unsigned char* lds;
    volatile LAS unsigned* MISC;
    gu32* ctl;
    int tid, lane, wave;
    int vcu, G;
};
struct Args { const float* in[29]; float* out; unsigned char* ws; int ph_lo, ph_hi, li, pad; };


constexpr size_t WS_MF = 768 * MiB;
constexpr size_t WS_EG = 800 * MiB;
constexpr size_t WS_A16 = 2 * MiB;
constexpr size_t WS_END2 = 816 * MiB;
static_assert(WS_END <= WS_MF, "ws map");

__device__ __forceinline__ void p0_ssm_item(const Args& a, int g, int t, LAS float* scr, int lane) {
    unsigned char* ws = a.ws;
    bf16_t* MFg = (bf16_t*)(ws + WS_MF) + (size_t)g * 256 * 384; bf16_t* Eg = (bf16_t*)(ws + WS_EG) + (size_t)g * 128 * 256; float* A16 = (float*)(ws + WS_A16) + (size_t)g * 128;
    const int p = lane, gp = g * NP + p;
    const double lr = a.in[8][gp], li = a.in[9][gp], dt = exp((double)a.in[10][g]);
    const double zr = lr * dt, zi = li * dt, mag = exp(zr), ar = mag * cos(zi), ai = mag * sin(zi);
    const double nr = ar - 1.0, ni = ai, den = lr * lr + li * li;
    const double cfr = (nr * lr + ni * li) / den, cfi = (ni * lr - nr * li) / den;
    double pr = 1.0, pi = 0.0;
    for (int k = 0; k < t; ++k) { const double x = pr * ar - pi * ai, y = pr * ai + pi * ar; pr = x; pi = y; }
    const double qr = pr * ar - pi * ai, qi = pr * ai + pi * ar;
    u32x4 er[2], ei[2];
#pragma unroll
    for (int c2 = 0; c2 < 8; ++c2) { float wr[2], wi[2];
#pragma unroll
        for (int e = 0; e < 2; ++e) { const int c = 2 * c2 + e; const double br = a.in[11][(size_t)gp * GC + c], bi = a.in[12][(size_t)gp * GC + c];
            const double bbr = cfr * br - cfi * bi, bbi = cfr * bi + cfi * br;
            wr[e] = (float)(pr * bbr - pi * bbi); wi[e] = (float)(pr * bbi + pi * bbr);
            scr[p * 16 + c] = wr[e]; scr[1024 + p * 16 + c] = wi[e]; }
        er[c2 >> 2][c2 & 3] = pk2(wr[0], wr[1]); ei[c2 >> 2][c2 & 3] = pk2(wi[0], wi[1]); }
    { const int j = 15 - t; bf16_t* e0 = Eg + (size_t)p * 256 + 16 * j; bf16_t* e1 = Eg + (size_t)(64 + p) * 256 + 16 * j;
      *(u32x4*)e0 = er[0]; *(u32x4*)(e0 + 8) = er[1]; *(u32x4*)e1 = ei[0]; *(u32x4*)(e1 + 8) = ei[1]; }
    const float fqr = (float)qr, fqi = (float)qi;
#pragma unroll
    for (int c = 0; c < GC; ++c) { const float cr = a.in[13][((size_t)g * GC + c) * NP + p], ci = a.in[14][((size_t)g * GC + c) * NP + p];
        scr[2048 + c * 64 + p] = cr; scr[3072 + c * 64 + p] = ci;
        bf16_t* fr_ = MFg + (size_t)(16 * t + c) * 384 + 256 + p;
        fr_[0] = (bf16_t)f2bf(cr * fqr - ci * fqi); fr_[64] = (bf16_t)f2bf(-(cr * fqi + ci * fqr)); }
    if (t == 15) { A16[p] = fqr; A16[64 + p] = fqi; }
    LDS_WAIT(); asm volatile("" ::: "memory");
    const int c = lane >> 2, c0 = (lane & 3) * 4; f32x4 acc = (f32x4){0.f, 0.f, 0.f, 0.f};
    for (int q = 0; q < NP; ++q) { const float cr = scr[2048 + c * 64 + q], ci = scr[3072 + c * 64 + q];
        const f32x4 wr = *(const LAS f32x4*)(scr + q * 16 + c0), wi = *(const LAS f32x4*)(scr + 1024 + q * 16 + c0);
        acc += wr * cr - wi * ci; }
    u32x2 kv; kv.x = pk2(acc[0], acc[1]); kv.y = pk2(acc[2], acc[3]);
    for (int i = t; i < 16; ++i) *(u32x2*)(MFg + (size_t)(16 * i + c) * 384 + 16 * (i - t) + c0) = kv;
    if (t >= 1) for (int i = 0; i + t < 16; ++i) *(u32x2*)(MFg + (size_t)(16 * i + c) * 384 + 16 * (i + t) + c0) = (u32x2){0u, 0u};
    LDS_WAIT(); asm volatile("" ::: "memory");
}

constexpr int SSM_UST = 264, SSM_HST = 136;
constexpr int SSM_U_OFF = 0, SSM_H_OFF = SSM_U_OFF + 32 * SSM_UST * 2, SSM_S_OFF = SSM_H_OFF + 32 * SSM_HST * 2, SSM_LDS_END = SSM_S_OFF + 128 * 33 * 4;
static_assert(SSM_LDS_END <= RING_BYTES, "ssm lds");
__device__ __forceinline__ float gelu_fast(float x) { const float t = 1.5957691216057308f * (x + 0.044715f * x * x * x); return x * __builtin_amdgcn_rcpf(1.f + __builtin_amdgcn_exp2f(-1.4426950408889634f * t)); }

__device__ __forceinline__ void p2_ssm(Frame& F, const Args& a) {
    const int g = F.vcu >> 1, hf = F.vcu & 1; if (g >= NG) return;
    unsigned char* ws = a.ws;
    const bf16_t* MFg = (const bf16_t*)(ws + WS_MF) + (size_t)g * 256 * 384; const bf16_t* Eg = (const bf16_t*)(ws + WS_EG) + (size_t)g * 128 * 256; const float* A16 = (const float*)(ws + WS_A16) + (size_t)g * 128;
    const bf16_t* Ub = (const bf16_t*)(ws + WS_UB); bf16_t* Yg = (bf16_t*)(ws + WS_YG);
    const int w = F.wave, lane = F.lane, fr = lane & 15, fq = lane >> 4, tid = F.tid;
    const int iw = w < 4 ? w : 11 - w, ti = 2 * iw + hf;
    LAS bf16_t* Ul = (LAS bf16_t*)(F.lds + SSM_U_OFF); LAS bf16_t* Hl = (LAS bf16_t*)(F.lds + SSM_H_OFF); LAS float* Sl = (LAS float*)(F.lds + SSM_S_OFF);
    bf16x8 mf[12], ef[8];
#pragma unroll
    for (int ks = 0; ks < 12; ++ks) mf[ks] = *(const bf16x8*)(MFg + (size_t)(16 * ti + fr) * 384 + 32 * ks + 8 * fq);
#pragma unroll
    for (int ks = 0; ks < 8; ++ks) ef[ks] = *(const bf16x8*)(Eg + (size_t)(16 * w + fr) * 256 + 32 * ks + 8 * fq);
    float a16r = 0.f, a16i = 0.f, hr = 0.f, hi = 0.f;
    if (w == 0) { a16r = A16[lane]; a16i = A16[64 + lane]; }
    f32x4 dsk = *(const f32x4*)(a.in[15] + g * GC + 4 * fq);
    u32x4 u0 = *(const u32x4*)(Ub + (size_t)tid * DM + g * GC), u1 = *(const u32x4*)(Ub + (size_t)tid * DM + g * GC + 8);
    for (int blk = 0; blk < 17; ++blk) {
        { LAS bf16_t* d = Ul + (tid >> 4) * SSM_UST + (tid & 15) * 16; *(LAS u32x4*)d = u0; *(LAS u32x4*)(d + 8) = u1; }
        __syncthreads();
        if (blk + 1 < 17) { const bf16_t* s = Ub + (size_t)(512 * (blk + 1) + tid) * DM + g * GC; u0 = *(const u32x4*)s; u1 = *(const u32x4*)(s + 8); }
#pragma unroll
        for (int nb = 0; nb < 2; ++nb) { f32x4 s = (f32x4){0.f, 0.f, 0.f, 0.f};
            bf16x8 ub[8];
#pragma unroll
            for (int ks = 0; ks < 8; ++ks) ub[ks] = *(const LAS bf16x8*)(Ul + (16 * nb + fr) * SSM_UST + 32 * ks + 8 * fq);
#pragma unroll
            for (int ks = 0; ks < 8; ++ks) s = __builtin_amdgcn_mfma_f32_16x16x32_bf16(ef[ks], ub[ks], s, 0, 0, 0);
#pragma unroll
            for (int r = 0; r < 4; ++r) Sl[(16 * w + 4 * fq + r) * 33 + 16 * nb + fr] = s[r]; }
        __syncthreads();
        if (w == 0) {
            float sr[32], si[32];
#pragma unroll
            for (int c = 0; c < 32; ++c) { sr[c] = Sl[lane * 33 + c]; si[c] = Sl[(64 + lane) * 33 + c]; }
            if (blk < 16) {
#pragma unroll
                for (int c = 0; c < 32; ++c) { Hl[c * SSM_HST + lane] = (bf16_t)f2bf(hr); Hl[c * SSM_HST + 64 + lane] = (bf16_t)f2bf(hi);
                    const float nr = a16r * hr - a16i * hi + sr[c], ni = a16r * hi + a16i * hr + si[c]; hr = nr; hi = ni; }
                if (blk == 15 && hf == 0) { a.out[O_REP + g * NP + lane] = hr; a.out[O_IMP + g * NP + lane] = hi; }
            } else {
#pragma unroll 4
                for (int b = 0; b < 32; ++b) { const float h0r = a.in[2][((size_t)b * NG + g) * NP + lane], h0i = a.in[3][((size_t)b * NG + g) * NP + lane];
                    Hl[b * SSM_HST + lane] = (bf16_t)f2bf(h0r); Hl[b * SSM_HST + 64 + lane] = (bf16_t)f2bf(h0i);
                    if (hf == 0) { a.out[O_RES + ((size_t)b * NG + g) * NP + lane] = a16r * h0r - a16i * h0i + sr[b]; a.out[O_IMS + ((size_t)b * NG + g) * NP + lane] = a16r * h0i + a16i * h0r + si[b]; } }
            }
        }
        __syncthreads();
#pragma unroll
        for (int nb = 0; nb < 2; ++nb) {
            bf16x8 hb[4], ub[8];
#pragma unroll
            for (int ks = 0; ks < 8; ++ks) ub[ks] = *(const LAS bf16x8*)(Ul + (16 * nb + fr) * SSM_UST + 32 * ks + 8 * fq);
#pragma unroll
            for (int kk = 0; kk < 4; ++kk) hb[kk] = *(const LAS bf16x8*)(Hl + (16 * nb + fr) * SSM_HST + 32 * kk + 8 * fq);
            f32x4 y = (f32x4){0.f, 0.f, 0.f, 0.f};
#pragma unroll
            for (int ks = 0; ks < 8; ++ks) if (ks <= iw) y = __builtin_amdgcn_mfma_f32_16x16x32_bf16(mf[ks], ub[ks], y, 0, 0, 0);
#pragma unroll
            for (int kk = 0; kk < 4; ++kk) y = __builtin_amdgcn_mfma_f32_16x16x32_bf16(mf[8 + kk], hb[kk], y, 0, 0, 0);
            const int ch = 16 * nb + fr;
            const u32x2 uu = *(const LAS u32x2*)(Ul + ch * SSM_UST + 16 * ti + 4 * fq);
            const f32x4 uf = (f32x4){bflo(uu.x), bfhi(uu.x), bflo(uu.y), bfhi(uu.y)};
            y += dsk * uf;
            u32x2 o; o.x = pk2(gelu_fast(y[0]), gelu_fast(y[1])); o.y = pk2(gelu_fast(y[2]), gelu_fast(y[3]));
            *(u32x2*)(Yg + (size_t)(512 * blk + 16 * ch + ti) * DM + g * GC + 4 * fq) = o;
        }
        __syncthreads();
    }
}

namespace att {
typedef float f32x8 __attribute__((ext_vector_type(8)));
typedef short s16x4 __attribute__((ext_vector_type(4)));
constexpr float THR = 8.f;
constexpr int KIMG = 16384, KSLOT = 2 * KIMG, VSLOT = 32768, V_OFF = 2 * KSLOT;
constexpr int Q_OFF = 131072 + 1024;
constexpr int OFFS_OFF = 131072 + 2048;
static_assert(OFFS_OFF + 512 * 32 <= LDS_BYTES, "attention LDS map");
typedef float f32x2_t __attribute__((ext_vector_type(2))); typedef __bf16 bf16x2_t __attribute__((ext_vector_type(2)));
__device__ __forceinline__ unsigned cvtpk(float lo, float hi) { f32x2_t v = {lo, hi}; bf16x2_t b = __builtin_convertvector(v, bf16x2_t); return __builtin_bit_cast(unsigned, b); }
__device__ __forceinline__ bf16x8 tobf(const f32x8& x) { u32x4 w = {cvtpk(x[0], x[1]), cvtpk(x[2], x[3]), cvtpk(x[4], x[5]), cvtpk(x[6], x[7])}; return __builtin_bit_cast(bf16x8, w); }
__device__ __forceinline__ int fK(int row) { return (((row >> 3) & 3) << 2) | (row & 3); }
__device__ __forceinline__ int xV(int row) { return (((row >> 3) & 3) << 3) | ((row & 3) << 1); }
__device__ __forceinline__ int k_st(int row, int c) { return row * 256 + 16 * (c ^ fK(row)); }
__device__ __forceinline__ int v_st(int row, int c) { return row * 512 + 16 * (c ^ xV(row)); }
__device__ __forceinline__ float grp_max(float v) {
    { auto rr = __builtin_amdgcn_permlane16_swap(__float_as_uint(v), __float_as_uint(v), false, false); v = fmaxf(__uint_as_float(rr[0]), __uint_as_float(rr[1])); }
    { auto rr = __builtin_amdgcn_permlane32_swap(__float_as_uint(v), __float_as_uint(v), false, false); v = fmaxf(__uint_as_float(rr[0]), __uint_as_float(rr[1])); }
    return v;
}
__device__ __forceinline__ float grp_sum(float v) {
    { auto rr = __builtin_amdgcn_permlane16_swap(__float_as_uint(v), __float_as_uint(v), false, false); v = __uint_as_float(rr[0]) + __uint_as_float(rr[1]); }
    { auto rr = __builtin_amdgcn_permlane32_swap(__float_as_uint(v), __float_as_uint(v), false, false); v = __uint_as_float(rr[0]) + __uint_as_float(rr[1]); }
    return v;
}
struct Rd { int ka[4]; int vb; int vk; };
__device__ __forceinline__ void make_rd(Rd& R, int lane) {
    const int i = lane & 15, dq = lane >> 4;
#pragma unroll
    for (int ds = 0; ds < 4; ++ds) R.ka[ds] = (8 * (i >> 2) + (i & 3)) * 256 + 16 * (dq ^ (i & 3)) + 64 * (ds ^ (i >> 2));
    const int g = lane >> 4, q = (lane & 15) >> 2, p = lane & 3;
    R.vb = (8 * g + q) * 512 + 16 * (p >> 1) + 8 * (p & 1); R.vk = 4 * g + q;
}
__device__ __forceinline__ void scores(f32x4 (&s)[4], const LAS unsigned char* Kimg, const Rd& R, const bf16x8 (&q16)[4], float m_ref) {
#pragma unroll
    for (int kb = 0; kb < 4; ++kb) { s[kb] = (f32x4){-m_ref, -m_ref, -m_ref, -m_ref};
#pragma unroll
        for (int ds = 0; ds < 4; ++ds) { const bf16x8 kf = *(const LAS bf16x8*)(Kimg + R.ka[ds] + (32 * (kb >> 1) + 4 * (kb & 1)) * 256);
            s[kb] = __builtin_amdgcn_mfma_f32_16x16x32_bf16(kf, q16[ds], s[kb], 0, 0, 0); } }
}
__device__ __forceinline__ float max3f(float a, float b, float c) { return fmaxf(fmaxf(a, b), c); }
__device__ __forceinline__ void softmax(f32x4 (&s)[4], float& m_reg, float& l_reg, float& alpha, bf16x8 (&pa)[2], bool first) {
    float pmax = fmaxf(max3f(max3f(s[0][0], s[0][1], s[0][2]), max3f(s[0][3], s[1][0], s[1][1]), max3f(s[1][2], s[1][3], s[2][0])),
                       max3f(max3f(s[2][1], s[2][2], s[2][3]), max3f(s[3][0], s[3][1], s[3][2]), s[3][3]));
    pmax = grp_max(pmax);
    if (__builtin_expect(!first && __all(pmax <= THR), 1)) { alpha = 1.f; }
    else { const float d = first ? pmax : fmaxf(pmax, 0.f); alpha = first ? 0.f : __builtin_amdgcn_exp2f(-d); m_reg += d;
#pragma unroll
        for (int kb = 0; kb < 4; ++kb) s[kb] -= d; }
    float ps = 0.f;
#pragma unroll
    for (int kb = 0; kb < 4; ++kb)
#pragma unroll
        for (int r = 0; r < 4; ++r) { s[kb][r] = __builtin_amdgcn_exp2f(s[kb][r]); ps += s[kb][r]; }
    ps = grp_sum(ps);
    l_reg = l_reg * alpha + ps;
#pragma unroll
    for (int st = 0; st < 2; ++st) { u32x4 w = {cvtpk(s[2 * st][0], s[2 * st][1]), cvtpk(s[2 * st][2], s[2 * st][3]), cvtpk(s[2 * st + 1][0], s[2 * st + 1][1]), cvtpk(s[2 * st + 1][2], s[2 * st + 1][3])};
        pa[st] = __builtin_bit_cast(bf16x8, w); }
}
template <int OFF> __device__ __forceinline__ s16x4 tr_read(int vb) { s16x4 r; asm volatile("ds_read_b64_tr_b16 %0, %1 offset:%2" : "=&v"(r) : "v"(vb), "i"(OFF) : "memory"); return r; }
#define VFR(lo, hi) (bf16x8){lo[0], lo[1], lo[2], lo[3], hi[0], hi[1], hi[2], hi[3]}
struct NoFill { __device__ __forceinline__ void operator()(int) const {} };
template <class Fill> __device__ __forceinline__ void pv2(f32x4 (&o1)[16], f32x4 (&o2)[16], int vbase, const Rd& R, const bf16x8 (&p1)[2], const bf16x8 (&p2)[2], const Fill& fill) {
    int vk = R.vk, vb = R.vb + vbase; asm volatile("" : "+v"(vk), "+v"(vb));
    s16x4 a0, a1, b0, b1, c0, c1, d0, d1;
    { const int v0 = vb + 32 * (0 ^ vk); a0 = tr_read<0>(v0); a1 = tr_read<4 * 512>(v0); b0 = tr_read<32 * 512>(v0); b1 = tr_read<36 * 512>(v0); }
#pragma unroll
    for (int cb = 0; cb < 16; cb += 2) {
        { const int v1 = vb + 32 * ((cb + 1) ^ vk); c0 = tr_read<0>(v1); c1 = tr_read<4 * 512>(v1); d0 = tr_read<32 * 512>(v1); d1 = tr_read<36 * 512>(v1); }
        asm volatile("s_waitcnt lgkmcnt(4)" : "+v"(a0), "+v"(a1), "+v"(b0), "+v"(b1) :: "memory"); __builtin_amdgcn_sched_barrier(0);
        { const bf16x8 fa = VFR(a0, a1), fb = VFR(b0, b1);
          o1[cb] = __builtin_amdgcn_mfma_f32_16x16x32_bf16(fa, p1[0], o1[cb], 0, 0, 0); o2[cb] = __builtin_amdgcn_mfma_f32_16x16x32_bf16(fa, p2[0], o2[cb], 0, 0, 0);
          o1[cb] = __builtin_amdgcn_mfma_f32_16x16x32_bf16(fb, p1[1], o1[cb], 0, 0, 0); o2[cb] = __builtin_amdgcn_mfma_f32_16x16x32_bf16(fb, p2[1], o2[cb], 0, 0, 0); }
        __builtin_amdgcn_sched_barrier(0);
        if (cb + 2 < 16) { const int v0 = vb + 32 * ((cb + 2) ^ vk); a0 = tr_read<0>(v0); a1 = tr_read<4 * 512>(v0); b0 = tr_read<32 * 512>(v0); b1 = tr_read<36 * 512>(v0);
            asm volatile("s_waitcnt lgkmcnt(4)" : "+v"(c0), "+v"(c1), "+v"(d0), "+v"(d1) :: "memory"); }
        else asm volatile("s_waitcnt lgkmcnt(0)" : "+v"(c0), "+v"(c1), "+v"(d0), "+v"(d1) :: "memory");
        __builtin_amdgcn_sched_barrier(0);
        { const bf16x8 fc = VFR(c0, c1), fd = VFR(d0, d1);
          o1[cb + 1] = __builtin_amdgcn_mfma_f32_16x16x32_bf16(fc, p1[0], o1[cb + 1], 0, 0, 0); o2[cb + 1] = __builtin_amdgcn_mfma_f32_16x16x32_bf16(fc, p2[0], o2[cb + 1], 0, 0, 0);
          o1[cb + 1] = __builtin_amdgcn_mfma_f32_16x16x32_bf16(fd, p1[1], o1[cb + 1], 0, 0, 0); o2[cb + 1] = __builtin_amdgcn_mfma_f32_16x16x32_bf16(fd, p2[1], o2[cb + 1], 0, 0, 0); }
        fill(cb >> 1);
        __builtin_amdgcn_sched_barrier(0);
    }
}
__device__ __forceinline__ void pv1(f32x4 (&o)[16], int vbase, const Rd& R, const bf16x8 (&p)[2]) {
    int vk = R.vk, vb = R.vb + vbase; asm volatile("" : "+v"(vk), "+v"(vb));
    s16x4 a0, a1, b0, b1, c0, c1, d0, d1;
    { const int v0 = vb + 32 * (0 ^ vk); a0 = tr_read<0>(v0); a1 = tr_read<4 * 512>(v0); b0 = tr_read<32 * 512>(v0); b1 = tr_read<36 * 512>(v0); }
#pragma unroll
    for (int cb = 0; cb < 16; cb += 2) {
        { const int v1 = vb + 32 * ((cb + 1) ^ vk); c0 = tr_read<0>(v1); c1 = tr_read<4 * 512>(v1); d0 = tr_read<32 * 512>(v1); d1 = tr_read<36 * 512>(v1); }
        asm volatile("s_waitcnt lgkmcnt(4)" : "+v"(a0), "+v"(a1), "+v"(b0), "+v"(b1) :: "memory"); __builtin_amdgcn_sched_barrier(0);
        o[cb] = __builtin_amdgcn_mfma_f32_16x16x32_bf16(VFR(a0, a1), p[0], o[cb], 0, 0, 0); o[cb] = __builtin_amdgcn_mfma_f32_16x16x32_bf16(VFR(b0, b1), p[1], o[cb], 0, 0, 0);
        __builtin_amdgcn_sched_barrier(0);
        if (cb + 2 < 16) { const int v0 = vb + 32 * ((cb + 2) ^ vk); a0 = tr_read<0>(v0); a1 = tr_read<4 * 512>(v0); b0 = tr_read<32 * 512>(v0); b1 = tr_read<36 * 512>(v0);
            asm volatile("s_waitcnt lgkmcnt(4)" : "+v"(c0), "+v"(c1), "+v"(d0), "+v"(d1) :: "memory"); }
        else asm volatile("s_waitcnt lgkmcnt(0)" : "+v"(c0), "+v"(c1), "+v"(d0), "+v"(d1) :: "memory");
        __builtin_amdgcn_sched_barrier(0);
        o[cb + 1] = __builtin_amdgcn_mfma_f32_16x16x32_bf16(VFR(c0, c1), p[0], o[cb + 1], 0, 0, 0); o[cb + 1] = __builtin_amdgcn_mfma_f32_16x16x32_bf16(VFR(d0, d1), p[1], o[cb + 1], 0, 0, 0);
        __builtin_amdgcn_sched_barrier(0);
    }
}
#undef VFR
struct Ctx { const bf16_t* Qb; const bf16_t* Kb; const bf16_t* Vb; const bf16_t* SZ2; bf16_t* Ab; const float* ck; const float* cv; const float* subln; float lam; };

__device__ __forceinline__ void finish_rows(const Ctx& C, f32x4 (&o1)[16], const f32x4 (&o2)[16], float l1, float l2, int row, int h, int lane) {
    int g = lane >> 4; asm volatile("" : "+v"(g));
    const float f1 = 1.f / l1, f2 = -C.lam / l2; float ss = 0.f;
#pragma unroll
    for (int cb = 0; cb < 16; ++cb) { o1[cb] = o1[cb] * f1 + o2[cb] * f2; ss += (o1[cb][0] * o1[cb][0] + o1[cb][1] * o1[cb][1]) + (o1[cb][2] * o1[cb][2] + o1[cb][3] * o1[cb][3]); }
    ss = grp_sum(ss);
    const float rr = (1.0f / sqrtf(ss * (1.0f / 256.0f) + EPS)) * (1.0f - LAMBDA_INIT);
    const size_t rowoff = (size_t)row * DM + h * 256 + 4 * g;
#pragma unroll
    for (int cb = 0; cb < 16; ++cb) { const f32x4 sg = *(const f32x4*)(C.subln + 16 * cb + 4 * g); const u32x2 z = *(const u32x2*)(C.SZ2 + rowoff + 16 * cb);
        u32x2 ov; ov.x = pk2(o1[cb][0] * rr * sg[0] * bflo(z.x), o1[cb][1] * rr * sg[1] * bfhi(z.x)); ov.y = pk2(o1[cb][2] * rr * sg[2] * bflo(z.y), o1[cb][3] * rr * sg[3] * bfhi(z.y));
        *(u32x2*)(C.Ab + rowoff + 16 * cb) = ov; }
}
__device__ __forceinline__ void glds16(const void* gsrc, unsigned lds_dst) { unsigned keep;
    asm volatile("s_mov_b32 %0, m0\n\ts_mov_b32 m0, %2\n\ts_nop 0\n\tglobal_load_lds_dwordx4 %1, off\n\ts_mov_b32 m0, %0" : "=&s"(keep) : "v"(gsrc), "s"(lds_dst) : "memory"); }
#define WAIT_BAR(N) asm volatile("s_waitcnt vmcnt(" #N ") lgkmcnt(0)\n\ts_barrier" ::: "memory")
#define RFL(x) ((unsigned)__builtin_amdgcn_readfirstlane((int)(x)))
#define ATT_SCALE(o, a) do { _Pragma("unroll") for (int cb_ = 0; cb_ < 16; ++cb_) o[cb_] *= (a); } while (0)

template <int MODE> __device__ __forceinline__ void prompt_unit(const Ctx& C, LAS unsigned char* lds, int c, int h, int tid) {
    const int w = __builtin_amdgcn_readfirstlane(tid >> 6), lane = tid & 63;
    Rd R; make_rd(R, lane);
    bf16x8 q1[4], q2[4];
    { const bf16_t* Qw = C.Qb + (size_t)(128 * c + 16 * w + (lane & 15)) * DM + h * 256 + 8 * (lane >> 4);
#pragma unroll
      for (int ds = 0; ds < 4; ++ds) { q1[ds] = *(const bf16x8*)(Qw + 32 * ds); q2[ds] = *(const bf16x8*)(Qw + 128 + 32 * ds); } }
    const bf16_t* Kh = C.Kb + h * 256; const bf16_t* Vh = C.Vb + h * 256;
    const unsigned ldsb = (unsigned)(uintptr_t)lds;
    const unsigned kdst = ldsb + (unsigned)(w >> 2) * KIMG + (unsigned)(w & 3) * 4096u, vdst = ldsb + V_OFF + (unsigned)w * 4096u;
    const LAS u32x4* offs = (const LAS u32x4*)(lds + OFFS_OFF + tid * 32);
    auto dma_piece = [&](int k, int t, int b, const u32x4& ko, const u32x4& vo) {
        if (MODE >= 3 && MODE != 4) return;
        if (k < 4) glds16(Kh + (size_t)t * 64 * DM + ko[k], RFL(kdst + (unsigned)b * KSLOT + (unsigned)k * 1024u));
        else glds16(Vh + (size_t)t * 64 * DM + vo[k - 4], RFL(vdst + (unsigned)b * VSLOT + (unsigned)(k - 4) * 1024u)); };
    const int vb0 = (int)(uintptr_t)(lds + V_OFF);
    const int NT = 2 * c + 2, myNT = NT - (w < 4 ? 1 : 0);
    float m1 = 0.f, l1 = 0.f, m2 = 0.f, l2 = 0.f, al1 = 1.f, al2 = 1.f; f32x4 o1[16], o2[16]; f32x4 s[4]; bf16x8 pa1[2], pa2[2];
#pragma unroll
    for (int cb = 0; cb < 16; ++cb) { o1[cb] = (f32x4){0.f, 0.f, 0.f, 0.f}; o2[cb] = (f32x4){0.f, 0.f, 0.f, 0.f}; }
    { const u32x4 ko = offs[0], vo = offs[1];
#pragma unroll
      for (int k = 0; k < 8; ++k) dma_piece(k, 0, 0, ko, vo); }
    WAIT_BAR(0);
    if (w >= 4) __builtin_amdgcn_s_setprio(1);
    for (int j = 0; j < NT; ++j) {
        const bool more = j + 1 < NT;
        const u32x4 ko = offs[0], vo = offs[1];
        auto fill = [&](int k) { if (more) dma_piece(k, j + 1, (j + 1) & 1, ko, vo); };
        if (j < myNT && MODE != 4 && MODE != 7) {
            if (MODE != 6) {
            scores(s, lds + (j & 1) * KSLOT, R, q1, m1); fill(0); fill(1); softmax(s, m1, l1, al1, pa1, j == 0); fill(2); fill(3);
            scores(s, lds + (j & 1) * KSLOT + KIMG, R, q2, m2); fill(4); fill(5); softmax(s, m2, l2, al2, pa2, j == 0); fill(6); fill(7);
            if (__any(al1 < 1.f)) ATT_SCALE(o1, al1);
            if (__any(al2 < 1.f)) ATT_SCALE(o2, al2); }
            else { _Pragma("unroll") for (int k = 0; k < 8; ++k) fill(k); }
            if (MODE != 5) pv2(o1, o2, vb0 + (j & 1) * VSLOT, R, pa1, pa2, NoFill{});
        } else {
#pragma unroll
            for (int k = 0; k < 8; ++k) fill(k);
        }
        WAIT_BAR(0);
    }
    __builtin_amdgcn_s_setprio(0);
    finish_rows(C, o1, o2, l1, l2, 128 * c + 16 * w + (lane & 15), h, lane);
}

__device__ __forceinline__ void sample_unit(const Ctx& C, LAS unsigned char* lds, int b, int h, int tid) {
    const int w = __builtin_amdgcn_readfirstlane(tid >> 6), lane = tid & 63;
    const int row0 = MP + DS * b;
    if ((w & 3) >= 2) {
        const int lt = (((w >> 2) << 1) | (w & 1)) * 64 + lane, sr = lt >> 4, sc = (lt & 15) * 8;
        const float* kp = C.ck + (((size_t)b * PAST + sr) * NH + h) * 256 + sc; const float* vp = C.cv + (((size_t)b * PAST + sr) * NH + h) * 256 + sc;
        constexpr size_t RS = (size_t)NH * 256;
        f32x8 kf[8], vf[8];
#define LLOAD(t) do { const size_t ro = (size_t)(t) * 64 * RS; _Pragma("unroll") for (int i = 0; i < 4; ++i) { kf[2 * i] = *(const f32x8*)(kp + ro + (size_t)(16 * i) * RS); kf[2 * i + 1] = *(const f32x8*)(kp + ro + (size_t)(16 * i) * RS + 128); \
            vf[2 * i] = *(const f32x8*)(vp + ro + (size_t)(16 * i) * RS); vf[2 * i + 1] = *(const f32x8*)(vp + ro + (size_t)(16 * i) * RS + 128); } } while (0)
        LLOAD(0);
        for (int t = 0; t < 32; ++t) {
            LAS unsigned char* Kd = lds + (t & 1) * KSLOT; LAS unsigned char* Vd = lds + V_OFF + (t & 1) * VSLOT;
#pragma unroll
            for (int i = 0; i < 4; ++i) { const int kr = sr + 16 * i;
                *(LAS bf16x8*)(Kd + k_st(kr, sc >> 3)) = tobf(kf[2 * i]); *(LAS bf16x8*)(Kd + KIMG + k_st(kr, sc >> 3)) = tobf(kf[2 * i + 1]);
                *(LAS bf16x8*)(Vd + v_st(kr, sc >> 3)) = tobf(vf[2 * i]); *(LAS bf16x8*)(Vd + v_st(kr, 16 + (sc >> 3))) = tobf(vf[2 * i + 1]); }
            if (t + 1 < 32) LLOAD(t + 1);
            __syncthreads();
        }
#undef LLOAD
        { LAS unsigned char* Kd = lds; LAS unsigned char* Vd = lds + V_OFF;
#pragma unroll
          for (int i = 0; i < 4; ++i) { const int kr = sr + 16 * i; const bf16_t* ks = C.Kb + (size_t)(row0 + kr) * DM + h * 256 + sc; const bf16_t* vs = C.Vb + (size_t)(row0 + kr) * DM + h * 256 + sc;
              bf16x8 k0 = *(const bf16x8*)ks, k1 = *(const bf16x8*)(ks + 128), v0 = *(const bf16x8*)vs, v1 = *(const bf16x8*)(vs + 128);
              if (kr >= DS) { v0 = bf16x8{}; v1 = bf16x8{}; k0 = bf16x8{}; k1 = bf16x8{}; }
              *(LAS bf16x8*)(Kd + k_st(kr, sc >> 3)) = k0; *(LAS bf16x8*)(Kd + KIMG + k_st(kr, sc >> 3)) = k1;
              *(LAS bf16x8*)(Vd + v_st(kr, sc >> 3)) = v0; *(LAS bf16x8*)(Vd + v_st(kr, 16 + (sc >> 3))) = v1; } }
        __syncthreads();
    } else if ((w & 3) == 0) {
        const int n = w >> 2;
        Rd R; make_rd(R, lane);
        bf16x8 q[4];
        { const bf16_t* Qw = C.Qb + (size_t)(row0 + (lane & 15)) * DM + h * 256 + 128 * n + 8 * (lane >> 4);
#pragma unroll
          for (int ds = 0; ds < 4; ++ds) q[ds] = *(const bf16x8*)(Qw + 32 * ds); }
        const int vb0 = (int)(uintptr_t)(lds + V_OFF);
        float m = 0.f, l = 0.f, al; f32x4 o[16]; f32x4 s[4]; bf16x8 pa[2];
#pragma unroll
        for (int cb = 0; cb < 16; ++cb) o[cb] = (f32x4){0.f, 0.f, 0.f, 0.f};
        for (int t = 0; t < 33; ++t) {
            __syncthreads();
            scores(s, lds + (t & 1) * KSLOT + n * KIMG, R, q, m);
            if (t == 32) {
#pragma unroll
                for (int kb = 0; kb < 4; ++kb) if (kb >= 2 || (lane >> 4) >= 2) s[kb] = (f32x4){-1e30f, -1e30f, -1e30f, -1e30f}; }
            softmax(s, m, l, al, pa, t == 0);
            if (__any(al < 1.f)) ATT_SCALE(o, al);
            pv1(o, vb0 + (t & 1) * VSLOT, R, pa);
        }
        const float f = (n == 0 ? 1.f : -C.lam) / l;
        ATT_SCALE(o, f);
        LAS float* X = (LAS float*)lds;
        __syncthreads();
        if (n == 1) {
#pragma unroll
            for (int cb = 0; cb < 16; ++cb) *(LAS f32x4*)(X + (cb * 64 + lane) * 4) = o[cb]; }
        __syncthreads();
        if (n == 0) {
            int g = lane >> 4; asm volatile("" : "+v"(g)); float ss = 0.f;
#pragma unroll
            for (int cb = 0; cb < 16; ++cb) { o[cb] += *(const LAS f32x4*)(X + (cb * 64 + lane) * 4); ss += (o[cb][0] * o[cb][0] + o[cb][1] * o[cb][1]) + (o[cb][2] * o[cb][2] + o[cb][3] * o[cb][3]); }
            ss = grp_sum(ss);
            const float rr = (1.0f / sqrtf(ss * (1.0f / 256.0f) + EPS)) * (1.0f - LAMBDA_INIT);
            const size_t rowoff = (size_t)(row0 + (lane & 15)) * DM + h * 256 + 4 * g;
#pragma unroll
            for (int cb = 0; cb < 16; ++cb) { const f32x4 sg = *(const f32x4*)(C.subln + 16 * cb + 4 * g); const u32x2 z = *(const u32x2*)(C.SZ2 + rowoff + 16 * cb);
                u32x2 ov; ov.x = pk2(o[cb][0] * rr * sg[0] * bflo(z.x), o[cb][1] * rr * sg[1] * bfhi(z.x)); ov.y = pk2(o[cb][2] * rr * sg[2] * bflo(z.y), o[cb][3] * rr * sg[3] * bfhi(z.y));
                *(u32x2*)(C.Ab + rowoff + 16 * cb) = ov; } }
    } else {
        for (int t = 0; t < 33; ++t) __syncthreads();
    }
    if ((w & 3) != 0) { __syncthreads(); __syncthreads(); }
    __syncthreads();
}
#undef WAIT_BAR
#undef RFL
#undef ATT_SCALE
}

constexpr int CW_ATTQ = 2048;
constexpr int ATT_PER_HEAD = 64 + DB;
__device__ __forceinline__ void att_decode(int pos, bool& samp, int& a) {
    if (pos < 64) { samp = pos & 1; a = samp ? (pos >> 1) : 63 - (pos >> 1); return; }
    samp = false; a = 63 - (32 + (pos - 64));
}
template <int MODE> __device__ __forceinline__ void p6_attn(Frame& F, const Args& a, int rep) {
    unsigned char* ws = a.ws;
    att::Ctx C{(const bf16_t*)(ws + WS_QB), (const bf16_t*)(ws + WS_KB), (const bf16_t*)(ws + WS_VB), (const bf16_t*)(ws + WS_SZ2), (bf16_t*)(ws + WS_AB), a.in[4], a.in[5], a.in[26], ((const float*)(ws + WS_SMALL + SM_LAM))[0]};
    volatile LAS int* qw = (volatile LAS int*)(F.lds + att::Q_OFF);
    { const int w = F.wave, lane = F.lane; u32x4 ko, vo;
#pragma unroll
      for (int pc = 0; pc < 4; ++pc) { { const int L = (4 * (w & 3) + pc) * 1024 + lane * 16, row = L >> 8, cc = (lane & 15) ^ att::fK(row); ko[pc] = (unsigned)row * DM + 128 * (w >> 2) + 8 * cc; }
          { const int L = (4 * w + pc) * 1024 + lane * 16, row = L >> 9, cc = ((L >> 4) & 31) ^ att::xV(row); vo[pc] = (unsigned)row * DM + 8 * cc; } }
      LAS u32x4* o = (LAS u32x4*)(F.lds + att::OFFS_OFF + F.tid * 32); o[0] = ko; o[1] = vo; }
    __syncthreads();
    const int x = (int)(xb_xcc_id() & 7u);
    for (int k = 0; k < NH; ++k) {
        const int h = (x + k) & 7;
        for (;;) {
            if (F.tid == 0) *qw = (int)__hip_atomic_fetch_add((unsigned*)(F.ctl + CW_ATTQ + (rep * NH + h) * 16), 1u, __ATOMIC_RELAXED, __HIP_MEMORY_SCOPE_AGENT);
            __syncthreads();
            const int pos = *qw;
            __syncthreads();
            if (pos >= ATT_PER_HEAD) break;
            bool samp; int ua; att_decode(pos, samp, ua);
            if ((MODE != 0 && MODE != 2 && samp) || (MODE == 2 && !samp)) continue;
            if (samp) att::sample_unit(C, F.lds, ua, h, F.tid); else att::prompt_unit<MODE>(C, F.lds, ua, h, F.tid);
        }
    }
}

template <bool PERM5> __device__ __forceinline__ void p0_transpose_item(const float* W, const float* g, int K, int N, bf16_t* WT, int row_off, LAS float* scr, int item, int lane) {
    const int nblk = N / 64, kb = item / nblk, nb = item % nblk, k0 = 32 * kb, n0 = 64 * nb;
    f32x4 v[8];
#pragma unroll
    for (int i = 0; i < 8; ++i) v[i] = *(const f32x4*)(W + (size_t)(k0 + 4 * i + (lane >> 4)) * N + n0 + 4 * (lane & 15));
#pragma unroll
    for (int i = 0; i < 8; ++i) *(LAS f32x4*)(scr + (4 * i + (lane >> 4)) * 68 + 4 * (lane & 15)) = v[i];
    const int c = lane & 3;
    f32x4 g0 = (f32x4){1.f, 1.f, 1.f, 1.f}, g1 = g0;
    if (g) { g0 = *(const f32x4*)(g + k0 + 8 * c); g1 = *(const f32x4*)(g + k0 + 8 * c + 4); }
    LDS_WAIT(); asm volatile("" ::: "memory");
#pragma unroll
    for (int j = 0; j < 4; ++j) { const int n = (lane >> 2) + 16 * j; const LAS float* s = scr + (8 * c) * 68 + n;
        u32x4 o; o.x = pk2(s[0 * 68] * g0[0], s[1 * 68] * g0[1]); o.y = pk2(s[2 * 68] * g0[2], s[3 * 68] * g0[3]); o.z = pk2(s[4 * 68] * g1[0], s[5 * 68] * g1[1]); o.w = pk2(s[6 * 68] * g1[2], s[7 * 68] * g1[3]);
        const int row = row_off + (PERM5 ? wt5_row(n0 + n) : n0 + n);
        *(u32x4*)(WT + (size_t)row * K + k0 + 8 * c) = o; }
    LDS_WAIT(); asm volatile("" ::: "memory");
}
__device__ __forceinline__ void p0_row(const float* xrow, bf16_t* orow, float* rs, int lane) {
    const f32x4* xr = (const f32x4*)xrow + lane;
    f32x4 v[8]; float s = 0.f;
#pragma unroll
    for (int j = 0; j < 8; ++j) { v[j] = xr[64 * j]; s += (v[j].x * v[j].x + v[j].y * v[j].y) + (v[j].z * v[j].z + v[j].w * v[j].w); }
    s = wave_sum(s);
    if (lane == 0) *rs = 1.0f / sqrtf(s * (1.0f / DM) + EPS);
    unsigned long long* o8 = (unsigned long long*)orow + lane;
#pragma unroll
    for (int j = 0; j < 8; ++j) o8[64 * j] = (unsigned long long)pk2(v[j].x, v[j].y) | ((unsigned long long)pk2(v[j].z, v[j].w) << 32);
}
__device__ __forceinline__ void p0_prologue(Frame& F, const Args& a) {
    unsigned char* ws = a.ws;
    LAS float* scr = (LAS float*)(F.lds + RING_OFF + F.wave * 16384);
    const int gw = F.vcu * NWAVES + F.wave, NGW = F.G * NWAVES;
    bf16_t *Wt1 = (bf16_t*)(ws + WS_WT1), *Wtg = (bf16_t*)(ws + WS_WTG), *Wto = (bf16_t*)(ws + WS_WTO), *Wt5 = (bf16_t*)(ws + WS_WT5), *Wtb = (bf16_t*)(ws + WS_WTB);
    constexpr int I_BIG = (DM / 32) * (4096 / 64), I_SQ = (DM / 32) * (DM / 64);
    constexpr int NITEMS = 3 * I_BIG + 3 * I_SQ;
    for (int it = gw; it < NITEMS; it += NGW) {
        int r = it;
        if (r < I_BIG) { p0_transpose_item<false>(a.in[7], a.in[6], DM, 4096, Wt1, 0, scr, r, F.lane); continue; } r -= I_BIG;
        if (r < I_BIG) { p0_transpose_item<true>(a.in[19], a.in[18], DM, 4096, Wt5, 0, scr, r, F.lane); continue; } r -= I_BIG;
        if (r < I_BIG) { p0_transpose_item<true>(a.in[21], a.in[20], DM, 4096, Wt5, 4096, scr, r, F.lane); continue; } r -= I_BIG;
        if (r < I_SQ) { p0_transpose_item<false>(a.in[16], nullptr, DM, DM, Wtg, 0, scr, r, F.lane); continue; } r -= I_SQ;
        if (r < I_SQ) { p0_transpose_item<false>(a.in[17], nullptr, DM, DM, Wto, 0, scr, r, F.lane); continue; } r -= I_SQ;
        p0_transpose_item<false>(a.in[27], nullptr, DM, DM, Wtb, 0, scr, r, F.lane);
    }
    for (int it = gw; it < NG * 16; it += NGW) p0_ssm_item(a, it >> 4, it & 15, scr, F.lane);
    bf16_t* Xb = (bf16_t*)(ws + WS_XB); float* rs0 = (float*)(ws + WS_RS0);
    for (int m = gw; m < M; m += NGW) p0_row(m < MP ? a.in[0] + (size_t)m * DM : a.in[1] + (size_t)(m - MP) * DM, Xb + (size_t)m * DM, rs0 + m, F.lane);
    const int gt = F.vcu * (NWAVES * 64) + F.tid, NGT = F.G * NWAVES * 64;
    float* lam = (float*)(ws + WS_SMALL + SM_LAM);
    { float* z1 = (float*)(ws + WS_SSQ1) + (size_t)MP * NSSQ; float* z2 = (float*)(ws + WS_SSQ2) + (size_t)MP * NSSQ;
      for (int i = gt; i < MS * NSSQ; i += NGT) { z1[i] = 0.f; z2[i] = 0.f; } }
    float* rope = (float*)(ws + WS_ROPE);
    for (int idx = gt; idx < SEQ * 64; idx += NGT) {
        const int pos = idx >> 6, i = idx & 63;
        const float inv = (float)pow(10000.0, -(double)(2 * i) / 128.0);
        const float ang = (float)pos * inv;
        rope[idx] = (float)cos((double)ang); rope[(size_t)SEQ * 64 + idx] = (float)sin((double)ang);
    }
    if (blockIdx.x == 0 && F.tid == 0) { float s1 = 0.f, s2 = 0.f; for (int i = 0; i < HD; ++i) { s1 += a.in[22][i] * a.in[23][i]; s2 += a.in[24][i] * a.in[25][i]; } lam[0] = expf(s1) - expf(s2) + LAMBDA_INIT; }
}
__device__ __forceinline__ void p8_final(Frame& F, const Args& a) {
    const int gw = F.vcu * NWAVES + F.wave, NGW = F.G * NWAVES;
    const float* X2 = (const float*)(a.ws + WS_X2); const float* ssq = (const float*)(a.ws + WS_SSQ2); const f32x4* gn = (const f32x4*)a.in[28] + F.lane;
    for (int m = gw; m < M; m += NGW) {
        const f32x4* xr = (const f32x4*)(X2 + (size_t)m * DM) + F.lane; f32x4* yr = (f32x4*)(a.out + O_YP + (size_t)m * DM) + F.lane;
        float q = (F.lane < NSSQ) ? ssq[(size_t)m * NSSQ + F.lane] : 0.f; q = wave_sum(q);
        const float rs = 1.0f / sqrtf(q * (1.0f / DM) + EPS);
#pragma unroll
        for (int j = 0; j < 8; ++j) yr[64 * j] = xr[64 * j] * rs * gn[64 * j];
    }
}

template <int MODE> __global__ void __launch_bounds__(NWAVES * 64, 2) mk_fwd(Args args) {
    extern __shared__ __attribute__((aligned(16))) unsigned char lds[];
    Frame F;
    F.lds = (LAS unsigned char*)lds;
    F.MISC = (volatile LAS unsigned*)(F.lds + MISC_OFF);
    F.tid = threadIdx.x; F.lane = F.tid & 63; F.wave = __builtin_amdgcn_readfirstlane(F.tid >> 6);
    F.G = gridDim.x; { const int bx = blockIdx.x; F.vcu = (F.G % 8 == 0) ? (bx % 8) * (F.G / 8) + bx / 8 : bx; }
    unsigned char* ws = args.ws;
    F.ctl = (gu32*)(ws + WS_CTL);
    for (int u = F.tid; u < (LDS_BYTES - LDSCTL_OFF) / 4; u += NWAVES * 64) ((LAS unsigned*)(F.lds + LDSCTL_OFF))[u] = 0u;
    __syncthreads();
    XcdBarrier bar = xcd_barrier_post((unsigned*)(F.ctl + CW_BAR) + args.li * XCD_BAR_WORDS, F.MISC + 8);
    const int lo = args.ph_lo, hi = args.ph_hi;
#define IN(k) (lo <= (k) && (k) < hi)
#define REFRESH() do { int t_ = threadIdx.x; asm volatile("" : "+v"(t_)); F.tid = t_; F.lane = t_ & 63; } while (0)
#define BOTH(k) (IN(k) && IN((k) + 1))
    bf16_t *Wt1 = (bf16_t*)(ws + WS_WT1), *Wtg = (bf16_t*)(ws + WS_WTG), *Wto = (bf16_t*)(ws + WS_WTO), *Wt5 = (bf16_t*)(ws + WS_WT5), *Wtb = (bf16_t*)(ws + WS_WTB);
    bf16_t *Xb = (bf16_t*)(ws + WS_XB), *Ub = (bf16_t*)(ws + WS_UB), *SZ = (bf16_t*)(ws + WS_SZ), *Yg = (bf16_t*)(ws + WS_YG), *Ob = (bf16_t*)(ws + WS_OB), *X1b = (bf16_t*)(ws + WS_X1B),
           *Kb = (bf16_t*)(ws + WS_KB), *Vb = (bf16_t*)(ws + WS_VB), *Qb = (bf16_t*)(ws + WS_QB), *SZ2 = (bf16_t*)(ws + WS_SZ2), *Ab = (bf16_t*)(ws + WS_AB);
    float *X1 = (float*)(ws + WS_X1), *X2 = (float*)(ws + WS_X2), *ssq1 = (float*)(ws + WS_SSQ1), *ssq2 = (float*)(ws + WS_SSQ2);

    if (IN(0)) { REFRESH(); p0_prologue(F, args); if (BOTH(0)) xcd_barrier(bar); }
    if (IN(1)) { REFRESH();
        pg8::Gemm g{Xb, Wt1, MP, 4096, DM}; pg8::StaticOrder S; S.init(MP, 4096, F.G, (int)blockIdx.x);
        pg8::EpiUZ E{Ub, SZ, (const float*)(ws + WS_RS0)};
        pg8::gemm_phase<pg8::EpiUZ, pg8::StaticOrder, true, true>(F.lds + RING_OFF, g, S, E);
        sk::phase<4, 64>(F.lds + RING_OFF, Xb, Wt1, 4096, sk::EpiUZ{Ub, SZ, (const float*)(ws + WS_RS0)}, F.vcu, F.G);
        if (BOTH(1)) xcd_barrier(bar);
    }
    if (IN(2)) { REFRESH(); p2_ssm(F, args); if (BOTH(2)) xcd_barrier(bar); }
    if (IN(3)) { REFRESH();
        pg8::Gemm g{Yg, Wtg, MP, DM, DM}; pg8::StaticOrder S; S.init(MP, DM, F.G, (int)blockIdx.x);
        pg8::EpiGlu E{Yg, SZ, Ob};
        pg8::gemm_phase<pg8::EpiGlu, pg8::StaticOrder, true, true>(F.lds + RING_OFF, g, S, E);
        sk::phase<4, 32>(F.lds + RING_OFF, Yg, Wtg, DM, sk::EpiGlu{Yg, SZ, Ob}, F.vcu, F.G);
        if (BOTH(3)) xcd_barrier(bar);
    }
    if (IN(4)) { REFRESH();
        pg8::Gemm g{Ob, Wto, MP, DM, DM}; pg8::StaticOrder S; S.init(MP, DM, F.G, (int)blockIdx.x);
        pg8::EpiRes E{args.in[0], args.in[1], X1, X1b, ssq1};
        pg8::gemm_phase<pg8::EpiRes, pg8::StaticOrder, true, true>(F.lds + RING_OFF, g, S, E);
        sk::phase<4, 32>(F.lds + RING_OFF, Ob, Wto, DM, sk::EpiRes{args.in[1] - (size_t)MP * DM, X1, X1b, ssq1}, F.vcu, F.G);
        if (BOTH(4)) xcd_barrier(bar);
    }
    if (IN(5)) { REFRESH();
        pg8::Gemm g{X1b, Wt5, MP, 8192, DM}; pg8::StaticOrder S; S.init(MP, 8192, F.G, (int)blockIdx.x);
        pg8::EpiKVQZ E{ssq1, (const float*)(ws + WS_ROPE), args.out, Kb, Vb, Qb, SZ2};
        pg8::gemm_phase<pg8::EpiKVQZ, pg8::StaticOrder, true, true>(F.lds + RING_OFF, g, S, E);
        sk::phase<8, 64>(F.lds + RING_OFF, X1b, Wt5, 8192, sk::EpiKVQZ{ssq1, (const float*)(ws + WS_ROPE), args.out, Kb, Vb, Qb, SZ2}, F.vcu, F.G);
        if (BOTH(5)) xcd_barrier(bar);
    }
    if (IN(6)) { REFRESH(); p6_attn<MODE>(F, args, args.li); if (BOTH(6)) xcd_barrier(bar); }
    if (IN(7)) { REFRESH();
        pg8::Gemm g{Ab, Wtb, MP, DM, DM}; pg8::StaticOrder S; S.init(MP, DM, F.G, (int)blockIdx.x);
        pg8::EpiRes E{X1, X1 + (size_t)MP * DM, X2, nullptr, ssq2};
        pg8::gemm_phase<pg8::EpiRes, pg8::StaticOrder, true, true>(F.lds + RING_OFF, g, S, E);
        sk::phase<4, 32>(F.lds + RING_OFF, Ab, Wtb, DM, sk::EpiRes{X1, X2, nullptr, ssq2}, F.vcu, F.G);
        if (BOTH(7)) xcd_barrier(bar);
    }
    if (IN(8)) { REFRESH(); p8_final(F, args); }
#undef IN
#undef BOTH
}

static void launch_mk(int grid, const Args& base, int lo, int hi, int li, hipStream_t stream, int mode = 0) {
    Args a = base; a.ph_lo = lo; a.ph_hi = hi; a.li = li; a.pad = mode;
#ifdef MK_PROBE_MODE
    if (mode == MK_PROBE_MODE) { (void)hipFuncSetAttribute((const void*)mk_fwd<MK_PROBE_MODE>, hipFuncAttributeMaxDynamicSharedMemorySize, LDS_BYTES); hipLaunchKernelGGL(mk_fwd<MK_PROBE_MODE>, dim3(grid), dim3(NWAVES * 64), LDS_BYTES, stream, a); } else
#endif
    hipLaunchKernelGGL(mk_fwd<0>, dim3(grid), dim3(NWAVES * 64), LDS_BYTES, stream, a);
    const hipError_t le = hipPeekAtLastError();
    if (le != hipSuccess) fprintf(stderr, "kernel_launch: launch [%d,%d) failed: %s (grid %d)\n", lo, hi, hipGetErrorName(le), grid);
}
extern "C" void kernel_launch(void* const* d_in, const int* in_sizes, int n_in, void* d_out, int out_size, void* d_ws, size_t ws_size, hipStream_t stream) {
    static int grid = 0;
    if (grid == 0) {
        if (n_in != 29 || (size_t)out_size != O_END || ws_size < WS_END2) { fprintf(stderr, "kernel_launch: unexpected shapes (n_in %d out %d ws %zu)\n", n_in, out_size, ws_size); grid = -1; return; }
        int dev = 0, cus = 0, per_cu = 0;
        if (hipGetDevice(&dev) != hipSuccess || hipDeviceGetAttribute(&cus, hipDeviceAttributeMultiprocessorCount, dev) != hipSuccess) { grid = -1; return; }
        if (hipFuncSetAttribute((const void*)mk_fwd<0>, hipFuncAttributeMaxDynamicSharedMemorySize, LDS_BYTES) != hipSuccess) { fprintf(stderr, "kernel_launch: hipFuncSetAttribute failed\n"); grid = -1; return; }
        if (hipOccupancyMaxActiveBlocksPerMultiprocessor(&per_cu, (const void*)mk_fwd<0>, NWAVES * 64, LDS_BYTES) != hipSuccess || per_cu < 1) { fprintf(stderr, "kernel_launch: occupancy query says %d blocks per CU\n", per_cu); per_cu = 1; }
        (void)hipGetLastError();
        grid = cus;
        if (grid < 2 * NG) { fprintf(stderr, "kernel_launch: %d CUs: the S5 phase deals one (group, half) item per workgroup and needs %d; nothing launched\n", grid, 2 * NG); grid = -1; return; }
        if (grid > 2 * NG) grid = 2 * NG;
    }
    if (grid < 0) return;
    if (hipMemsetAsync((char*)d_ws + WS_CTL, 0, CTL_ZERO_BYTES, stream) != hipSuccess) { fprintf(stderr, "kernel_launch: memset failed\n"); return; }
    Args a{};
    for (int i = 0; i < 29; ++i) a.in[i] = (const float*)d_in[i];
    a.out = (float*)d_out; a.ws = (unsigned char*)d_ws;
    launch_mk(grid, a, 0, 9, 0, stream);
#ifdef MK_PROBE_PHASES
    { const int extra[] = {MK_PROBE_PHASES}; int li = 1;
      for (int k : extra) { launch_mk(grid, a, k % 100, k % 100 + 1, li, stream, k / 100); ++li; } }
#endif
}
```

```cpp
#include <hip/hip_runtime.h>
#include <cstdint>
#include <cstdio>
#include <cmath>

constexpr int DM = 2048, SEQ = 8192, DB = 32, DS = 16, PAST = 2048;
constexpr int MP = SEQ, MS = DB * DS, M = MP + MS;
constexpr int NG = 128, NP = 64, GC = 16;
constexpr int NH = 8, HD = 128, AW = 2048;
constexpr float EPS = 1e-6f;
constexpr float LAMBDA_INIT = 0.35550906759096995f;
constexpr float QSCALE = 0.08838834764831845f * 1.4426950408889634f;
constexpr int NSSQ = 32;

constexpr size_t O_YP = 0, O_YS = O_YP + (size_t)MP * DM, O_REP = O_YS + (size_t)MS * DM, O_IMP = O_REP + NG * NP,
                 O_KP = O_IMP + NG * NP, O_VP = O_KP + (size_t)MP * AW, O_RES = O_VP + (size_t)MP * AW, O_IMS = O_RES + (size_t)DB * NG * NP,
                 O_KS = O_IMS + (size_t)DB * NG * NP, O_VS = O_KS + (size_t)MS * AW, O_END = O_VS + (size_t)MS * AW;

constexpr size_t MiB = 1u << 20;
constexpr size_t WS_CTL = 0, CTL_ZERO_BYTES = 1 * MiB;
constexpr size_t WS_SMALL = 1 * MiB;
constexpr size_t SM_ABAR = 0;
constexpr size_t SM_BB = SM_ABAR + 2 * NG * NP * 4;
constexpr size_t SM_LAM = SM_BB + 2 * (size_t)NG * NP * GC * 4;
constexpr size_t SM_END = SM_LAM + 64;
static_assert(SM_END <= 2 * MiB, "small tables");
constexpr size_t WS_SSQ1 = 3 * MiB;
constexpr size_t WS_SSQ2 = 5 * MiB;
constexpr size_t WS_RS0 = 7 * MiB;
constexpr size_t WS_ROPE = 8 * MiB;
constexpr size_t WS_WT1 = 12 * MiB;
constexpr size_t WS_WTG = 28 * MiB;
constexpr size_t WS_WTO = 36 * MiB;
constexpr size_t WS_WT5 = 44 * MiB;
constexpr size_t WS_WTB = 76 * MiB;
constexpr size_t ACT = (size_t)M * DM * 2;
constexpr size_t WS_XB = 84 * MiB;
constexpr size_t WS_UB = WS_XB + 36 * MiB, WS_SZ = WS_UB + 36 * MiB, WS_YG = WS_SZ + 36 * MiB, WS_OB = WS_YG + 36 * MiB,
                 WS_X1B = WS_OB + 36 * MiB, WS_KB = WS_X1B + 36 * MiB, WS_VB = WS_KB + 36 * MiB, WS_QB = WS_VB + 36 * MiB,
                 WS_SZ2 = WS_QB + 36 * MiB, WS_AB = WS_SZ2 + 36 * MiB;
constexpr size_t WS_X1 = WS_AB + 36 * MiB;
constexpr size_t WS_X2 = WS_X1 + 72 * MiB;
constexpr size_t WS_END = WS_X2 + 72 * MiB;
static_assert(ACT <= 36 * MiB, "act");
constexpr int CW_TMO = 0, CW_CODE = 1;
constexpr int CW_BAR = 4096;

typedef unsigned short bf16_t;
typedef short bf16x8 __attribute__((ext_vector_type(8)));
typedef float f32x4 __attribute__((ext_vector_type(4)));
typedef unsigned u32x4 __attribute__((ext_vector_type(4)));
typedef unsigned u32x2 __attribute__((ext_vector_type(2)));

__device__ __forceinline__ unsigned f2bf(float f) { unsigned u = __builtin_bit_cast(unsigned, f); return (u + 0x7fffu + ((u >> 16) & 1u)) >> 16; }
__device__ __forceinline__ unsigned pk2(float lo, float hi) { return f2bf(lo) | (f2bf(hi) << 16); }
__device__ __forceinline__ float bf2f(unsigned short b) { return __builtin_bit_cast(float, (unsigned)b << 16); }
__device__ __forceinline__ float bflo(unsigned w) { return __builtin_bit_cast(float, w << 16); }
__device__ __forceinline__ float bfhi(unsigned w) { return __builtin_bit_cast(float, w & 0xffff0000u); }
__device__ __forceinline__ float wave_sum(float v) {
#pragma unroll
    for (int o = 1; o < 64; o <<= 1) v += __shfl_xor(v, o);
    return v;
}
__device__ __forceinline__ float wave_max(float v) {
#pragma unroll
    for (int o = 1; o < 64; o <<= 1) v = fmaxf(v, __shfl_xor(v, o));
    return v;
}
__device__ __forceinline__ float sigmoid_fast(float z) { return __builtin_amdgcn_rcpf(1.f + __builtin_amdgcn_exp2f(-1.4426950408889634f * z)); }
__device__ __forceinline__ float silu_fast(float z) { return z * sigmoid_fast(z); }
__device__ __forceinline__ float gelu_tanh_f(float x) { const float t = 0.7978845608028654f * (x + 0.044715f * x * x * x); return 0.5f * x * (1.f + tanhf(t)); }
__host__ __device__ __forceinline__ int wt5_row(int n) { const int tile = n >> 8, w = n & 255, blk = w >> 7, i = w & 127; return tile * 256 + (i >> 6) * 128 + blk * 64 + (i & 63); }
namespace pg8 {
#define PG8_LAS __attribute__((address_space(3)))
typedef unsigned short bf16_t;
typedef short bf16x8 __attribute__((ext_vector_type(8)));
typedef float f32x4 __attribute__((ext_vector_type(4)));
typedef unsigned u32x4 __attribute__((ext_vector_type(4)));
constexpr int BM = 256, BK = 64, HALF = 128, HTB = HALF * BK * 2  , STAGE_BYTES = 8 * HTB, NXCD = 8, WGM = 8;

__host__ __device__ __forceinline__ int lds_byte(int r, int c) { const int st = (r >> 4) * 2 + (c >> 5), rr = r & 15, cc = c & 31, ob = rr * 64 + cc * 2; return st * 1024 + (ob ^ (((ob >> 9) & 1) << 5)); }
__host__ __device__ __forceinline__ void stage_rc(int b, int& R, int& C) { const int st = b / 1024, sb = b % 1024, swz = sb ^ (((sb >> 9) & 1) << 5); R = (st >> 1) * 16 + swz / 64; C = (st & 1) * 32 + (swz % 64) / 2; }
__host__ __device__ __forceinline__ int perm32(int rho) { const int n = rho >> 4, i = rho & 15; return 8 * (i >> 2) + 4 * n + (i & 3); }

struct Unit { int pm, pn; };
struct Gemm { const bf16_t* A; const bf16_t* Bt; int M, N, K; };

struct StaticOrder {
    int nM, nN, nwg, G, c;
    __host__ __device__ void init(int M, int N, int G_, int c_) { nM = M / BM; nN = N / BM; nwg = nM * nN; G = G_; c = c_; }
    __host__ __device__ bool next(int i, Unit& u) const {
        const long L = (long)i * G + c; if (L >= nwg) return false;
        int wgid = (int)L; { const int q = nwg / NXCD, r = nwg % NXCD, xcd = wgid % NXCD, off = wgid / NXCD; wgid = (xcd < r ? xcd * (q + 1) : r * (q + 1) + (xcd - r) * q) + off; }
        const int nig = WGM * nN, gid = wgid / nig, fm = gid * WGM, gsz = (nM - fm) < WGM ? (nM - fm) : WGM;
        u.pm = fm + ((wgid % nig) % gsz); u.pn = (wgid % nig) / gsz; return true;
    }
    __device__ __forceinline__ void a_ready(const Unit&) const {}
    __device__ __forceinline__ void done(const Unit&) const {}
};

__device__ __forceinline__ unsigned cvt_pk_bf16(float lo, float hi) { unsigned r; asm volatile("v_cvt_pk_bf16_f32 %0, %1, %2" : "=v"(r) : "v"(lo), "v"(hi)); return r; }
__device__ __forceinline__ float sigm(float z) { return __builtin_amdgcn_rcpf(1.f + __builtin_amdgcn_exp2f(-1.4426950408889634f * z)); }
__device__ __forceinline__ u32x4 pack8(const f32x4& a, const f32x4& b) { u32x4 w; w.x = cvt_pk_bf16(a[0], a[1]); w.y = cvt_pk_bf16(a[2], a[3]); w.z = cvt_pk_bf16(b[0], b[1]); w.w = cvt_pk_bf16(b[2], b[3]); return w; }
__device__ __forceinline__ f32x4 unlo(const u32x4& w) { return (f32x4){__builtin_bit_cast(float, w.x << 16), __builtin_bit_cast(float, w.x & 0xffff0000u), __builtin_bit_cast(float, w.y << 16), __builtin_bit_cast(float, w.y & 0xffff0000u)}; }
__device__ __forceinline__ f32x4 unhi(const u32x4& w) { return (f32x4){__builtin_bit_cast(float, w.z << 16), __builtin_bit_cast(float, w.z & 0xffff0000u), __builtin_bit_cast(float, w.w << 16), __builtin_bit_cast(float, w.w & 0xffff0000u)}; }
__device__ __forceinline__ f32x4 silu4(const f32x4& v) { return (f32x4){v[0] * sigm(v[0]), v[1] * sigm(v[1]), v[2] * sigm(v[2]), v[3] * sigm(v[3])}; }
__device__ __forceinline__ f32x4 sigm4(const f32x4& v) { return (f32x4){sigm(v[0]), sigm(v[1]), sigm(v[2]), sigm(v[3])}; }

struct EpiUZ {
    static constexpr bool PERM = true, AFTER_DRAIN = false;
    bf16_t* Ub; bf16_t* SZ; const float* rs;
    __device__ __forceinline__ void operator()(const f32x4 (&acc)[2][2][4][2], const Unit& u, int wr, int wc, int fr, int fq) const {
        const int row0 = u.pm * BM + wr * 64 + fr; const bool isz = u.pn >= 8; bf16_t* base = isz ? SZ : Ub; const int col0 = (u.pn & 7) * BM + wc * 32 + 8 * fq;
#pragma unroll
        for (int ai = 0; ai < 2; ++ai)
#pragma unroll
            for (int m = 0; m < 4; ++m) { const int row = row0 + ai * HALF + m * 16; const float s = rs[row]; bf16_t* rowp = base + (size_t)row * 2048 + col0;
#pragma unroll
                for (int bj = 0; bj < 2; ++bj) { f32x4 v0 = acc[ai][bj][m][0] * s, v1 = acc[ai][bj][m][1] * s;
                    if (isz) { v0 = silu4(v0); v1 = silu4(v1); }
                    *(u32x4*)(rowp + bj * HALF) = pack8(v0, v1); } }
    }
};
struct EpiGlu {
    static constexpr bool PERM = true, AFTER_DRAIN = false;
    const bf16_t* Yg; const bf16_t* SZ; bf16_t* Ob;
    __device__ __forceinline__ void operator()(const f32x4 (&acc)[2][2][4][2], const Unit& u, int wr, int wc, int fr, int fq) const {
        const int row0 = u.pm * BM + wr * 64 + fr; const int col0 = u.pn * BM + wc * 32 + 8 * fq;
#pragma unroll
        for (int ai = 0; ai < 2; ++ai)
#pragma unroll
            for (int m = 0; m < 4; ++m) { const size_t off = (size_t)(row0 + ai * HALF + m * 16) * 2048 + col0;
#pragma unroll
                for (int bj = 0; bj < 2; ++bj) { const u32x4 y = *(const u32x4*)(Yg + off + bj * HALF), z = *(const u32x4*)(SZ + off + bj * HALF);
                    const f32x4 v0 = unlo(y) * sigm4(acc[ai][bj][m][0]) * unlo(z), v1 = unhi(y) * sigm4(acc[ai][bj][m][1]) * unhi(z);
                    *(u32x4*)(Ob + off + bj * HALF) = pack8(v0, v1); } }
    }
};
struct EpiRes {
    static constexpr bool PERM = true, AFTER_DRAIN = false;
    const float* base_p; const float* base_s; float* X; bf16_t* Xb; float* ssq;
    __device__ __forceinline__ void operator()(const f32x4 (&acc)[2][2][4][2], const Unit& u, int wr, int wc, int fr, int fq) const {
        const int row0 = u.pm * BM + wr * 64 + fr; const int col0 = u.pn * BM + wc * 32 + 8 * fq;
        const bool prm = u.pm < MP / BM; const float* bs = prm ? base_p : base_s; const size_t bsub = prm ? 0 : (size_t)MP * 2048;
#pragma unroll
        for (int ai = 0; ai < 2; ++ai)
#pragma unroll
            for (int m = 0; m < 4; ++m) { const int row = row0 + ai * HALF + m * 16; const size_t off = (size_t)row * 2048 + col0; float q = 0.f;
#pragma unroll
                for (int bj = 0; bj < 2; ++bj) { const f32x4 b0 = *(const f32x4*)(bs + (off - bsub) + bj * HALF), b1 = *(const f32x4*)(bs + (off - bsub) + bj * HALF + 4);
                    const f32x4 v0 = b0 + acc[ai][bj][m][0], v1 = b1 + acc[ai][bj][m][1];
                    *(f32x4*)(X + off + bj * HALF) = v0; *(f32x4*)(X + off + bj * HALF + 4) = v1;
                    q += (v0[0] * v0[0] + v0[1] * v0[1]) + (v0[2] * v0[2] + v0[3] * v0[3]) + (v1[0] * v1[0] + v1[1] * v1[1]) + (v1[2] * v1[2] + v1[3] * v1[3]);
                    if (Xb) *(u32x4*)(Xb + off + bj * HALF) = pack8(v0, v1); }
                q += __shfl_xor(q, 16); q += __shfl_xor(q, 32);
                if (fq == 0) ssq[(size_t)row * NSSQ + u.pn * 4 + wc] = q; }
    }
};
struct EpiKVQZ {
    static constexpr bool PERM = true, AFTER_DRAIN = false;
    const float* ssq; const float* rope; float* out; bf16_t* Kb; bf16_t* Vb; bf16_t* Qb; bf16_t* SZ2;
    __device__ __forceinline__ void operator()(const f32x4 (&acc)[2][2][4][2], const Unit& u, int wr, int wc, int fr, int fq) const {
        const int row0 = u.pm * BM + wr * 64 + fr; const int kind = u.pn >> 3; const int f0 = 32 * (wc & 1) + 8 * fq;
        const int lcol = (u.pn & 7) * BM + (wc >> 1) * 128 + f0;
        const bool prm = u.pm < MP / BM;
        float* ko = prm ? out + O_KP : out + O_KS; float* vo = prm ? out + O_VP : out + O_VS; const size_t osub = prm ? 0 : (size_t)MP * 2048;
#pragma unroll
        for (int ai = 0; ai < 2; ++ai)
#pragma unroll
            for (int m = 0; m < 4; ++m) { const int row = row0 + ai * HALF + m * 16; const size_t off = (size_t)row * 2048 + lcol;
                const f32x4 p0 = *(const f32x4*)(ssq + (size_t)row * NSSQ + 8 * fq), p1 = *(const f32x4*)(ssq + (size_t)row * NSSQ + 8 * fq + 4);
                float q = (p0[0] + p0[1]) + (p0[2] + p0[3]) + (p1[0] + p1[1]) + (p1[2] + p1[3]); q += __shfl_xor(q, 16); q += __shfl_xor(q, 32);
                const float rs = 1.0f / sqrtf(q * (1.0f / 2048.0f) + EPS);
                f32x4 a0 = acc[ai][0][m][0] * rs, a1 = acc[ai][0][m][1] * rs, b0 = acc[ai][1][m][0] * rs, b1 = acc[ai][1][m][1] * rs;
                if (kind == 0 || kind == 2) {
                    const int pos = prm ? row : PAST + ((row - MP) & 15);
                    const float* cp = rope + (size_t)pos * 64 + f0; const float* sp = cp + (size_t)SEQ * 64;
                    const f32x4 c0 = *(const f32x4*)cp, c1 = *(const f32x4*)(cp + 4), s0 = *(const f32x4*)sp, s1 = *(const f32x4*)(sp + 4);
                    const f32x4 y0 = a0 * c0 - b0 * s0, y1 = a1 * c1 - b1 * s1, z0 = a0 * s0 + b0 * c0, z1 = a1 * s1 + b1 * c1;
                    a0 = y0; a1 = y1; b0 = z0; b1 = z1;
                }
                if (kind == 0) { { float* o = ko + (off - osub); *(f32x4*)(o) = a0; *(f32x4*)(o + 4) = a1; *(f32x4*)(o + 64) = b0; *(f32x4*)(o + 68) = b1; }
                    *(u32x4*)(Kb + off) = pack8(a0, a1); *(u32x4*)(Kb + off + 64) = pack8(b0, b1); }
                else if (kind == 1) { { float* o = vo + (off - osub); *(f32x4*)(o) = a0; *(f32x4*)(o + 4) = a1; *(f32x4*)(o + 64) = b0; *(f32x4*)(o + 68) = b1; }
                    *(u32x4*)(Vb + off) = pack8(a0, a1); *(u32x4*)(Vb + off + 64) = pack8(b0, b1); }
                else if (kind == 2) { *(u32x4*)(Qb + off) = pack8(a0 * QSCALE, a1 * QSCALE); *(u32x4*)(Qb + off + 64) = pack8(b0 * QSCALE, b1 * QSCALE); }
                else { *(u32x4*)(SZ2 + off) = pack8(silu4(a0), silu4(a1)); *(u32x4*)(SZ2 + off + 64) = pack8(silu4(b0), silu4(b1)); } }
    }
};
template <class Epi, class Sched, bool ALIGN_EPI = false, bool SP2 = false>
__device__ __forceinline__ void gemm_phase(PG8_LAS unsigned char* lds, const Gemm g, const Sched& S, const Epi& E) {
    const int tid = threadIdx.x, wid = __builtin_amdgcn_readfirstlane(tid >> 6), lane = tid & 63, wr = wid >> 2, wc = wid & 3, fr = lane & 15, fq = lane >> 4;
    const int K = g.K, nt = K / BK;
    unsigned voffA[2], voffB[2];
#pragma unroll
    for (int i = 0; i < 2; ++i) { int R, C; stage_rc(tid * 16 + i * 8192, R, C); const int Rb = Epi::PERM ? ((R & ~31) + perm32(R & 31)) : R;
        voffA[i] = (unsigned)(R * K + C) * 2u; voffB[i] = (unsigned)(Rb * K + C) * 2u; }
    const size_t kstep = (size_t)(BK * 2);
    const size_t hstep = (size_t)HALF * K * 2;
    const size_t tstep = 2 * hstep;
    const unsigned ldsw = (unsigned)wid * 1024u;
    const int aoff = lds_byte(wr * 64 + fr, fq * 8), boff = lds_byte(wc * 32 + fr, fq * 8);
#define PG8_SA(b, h) (((b) * 2 + (h)) * HTB)
#define PG8_SB(b, h) ((4 + (b) * 2 + (h)) * HTB)
#define PG8_STAGE(bufoff, gbase, voff) do { _Pragma("unroll") for (int _i = 0; _i < 2; ++_i) \
        __builtin_amdgcn_global_load_lds((const unsigned*)((const char*)(gbase) + (voff)[_i]), (PG8_LAS unsigned*)(lds + (bufoff) + ldsw + _i * 8192), 16, 0, 0); } while (0)
#define PG8_LDA(dst, b, h) do { _Pragma("unroll") for (int m = 0; m < 4; ++m) _Pragma("unroll") for (int k = 0; k < 2; ++k) dst[m][k] = *(const PG8_LAS bf16x8*)(lds + PG8_SA(b, h) + aoff + m * 2048 + k * 1024); } while (0)
#define PG8_LDB(dst, b, h) do { _Pragma("unroll") for (int n = 0; n < 2; ++n) _Pragma("unroll") for (int k = 0; k < 2; ++k) dst[n][k] = *(const PG8_LAS bf16x8*)(lds + PG8_SB(b, h) + boff + n * 2048 + k * 1024); } while (0)
#define PG8_MMA(ai, bj, At, Bt) do { __builtin_amdgcn_s_setprio(1); _Pragma("unroll") for (int m = 0; m < 4; ++m) _Pragma("unroll") for (int n = 0; n < 2; ++n) _Pragma("unroll") for (int k = 0; k < 2; ++k) \
        acc[ai][bj][m][n] = __builtin_amdgcn_mfma_f32_16x16x32_bf16(Bt[n][k], At[m][k], acc[ai][bj][m][n], 0, 0, 0); __builtin_amdgcn_s_setprio(0); } while (0)
#define PG8_WAIT_V(n) asm volatile("s_waitcnt vmcnt(" #n ")" ::: "memory")
#define PG8_WAIT_L(n) asm volatile("s_waitcnt lgkmcnt(" #n ")" ::: "memory")
#define PG8_BAR __builtin_amdgcn_s_barrier()
#define PG8_SCHED __builtin_amdgcn_sched_barrier(0)
    Unit cur, nxt; int ui = 0;
    if (!S.next(0, cur)) return;
    f32x4 acc[2][2][4][2];
#pragma unroll
    for (int a = 0; a < 2; ++a)
#pragma unroll
        for (int b = 0; b < 2; ++b)
#pragma unroll
            for (int m = 0; m < 4; ++m)
#pragma unroll
                for (int n = 0; n < 2; ++n) acc[a][b][m][n] = (f32x4){0.f, 0.f, 0.f, 0.f};
    bf16x8 At[4][2], B0[2][2], B1[2][2];
    const char* cA = (const char*)g.A + (size_t)cur.pm * tstep; const char* cB = (const char*)g.Bt + (size_t)cur.pn * tstep;
    S.a_ready(cur);
    if constexpr (SP2) {
        PG8_STAGE(PG8_SB(0, 0), cB, voffB); PG8_STAGE(PG8_SB(0, 1), cB + hstep, voffB); PG8_STAGE(PG8_SA(0, 0), cA, voffA); PG8_STAGE(PG8_SA(0, 1), cA + hstep, voffA);
        if (wr == 1) PG8_BAR;
        PG8_WAIT_V(2); PG8_BAR;
        PG8_STAGE(PG8_SB(1, 0), cB + kstep, voffB); PG8_STAGE(PG8_SA(1, 0), cA + kstep, voffA); PG8_STAGE(PG8_SB(1, 1), cB + hstep + kstep, voffB);
        PG8_WAIT_V(6); PG8_BAR;
    } else {
        PG8_STAGE(PG8_SB(0, 0), cB, voffB); PG8_STAGE(PG8_SA(0, 0), cA, voffA); PG8_STAGE(PG8_SB(0, 1), cB + hstep, voffB); PG8_STAGE(PG8_SA(0, 1), cA + hstep, voffA);
        if (wr == 1) PG8_BAR;
        PG8_WAIT_V(4); PG8_BAR;
        PG8_STAGE(PG8_SB(1, 0), cB + kstep, voffB); PG8_STAGE(PG8_SA(1, 0), cA + kstep, voffA); PG8_STAGE(PG8_SB(1, 1), cB + hstep + kstep, voffB);
        PG8_WAIT_V(6); PG8_BAR;
    }
    for (;;) {
        const bool has_next = S.next(ui + 1, nxt);
        const char* nA = has_next ? (const char*)g.A + (size_t)nxt.pm * tstep : cA; const char* nB = has_next ? (const char*)g.Bt + (size_t)nxt.pn * tstep : cB;
        for (int t = 0; t < nt; t += 2) {
            const bool last = (t == nt - 2);
            const char* a1 = cA + (size_t)(t + 1) * kstep;
            const char* a2 = last ? nA : cA + (size_t)(t + 2) * kstep; const char* b2 = last ? nB : cB + (size_t)(t + 2) * kstep;
            const char* a3 = a2 + kstep; const char* b3 = b2 + kstep;
            if (last && has_next) S.a_ready(nxt);
            if constexpr (SP2) {
            PG8_LDB(B0, 0, 0); PG8_LDB(B1, 0, 1); PG8_SCHED; PG8_LDA(At, 0, 0); PG8_STAGE(PG8_SA(1, 1), a1 + hstep, voffA);
            PG8_WAIT_V(8); PG8_WAIT_L(0); PG8_BAR; PG8_MMA(0, 0, At, B0); PG8_MMA(0, 1, At, B1); PG8_BAR; PG8_SCHED;
            PG8_LDA(At, 0, 1); PG8_STAGE(PG8_SB(0, 0), b2, voffB); PG8_STAGE(PG8_SB(0, 1), b2 + hstep, voffB); PG8_STAGE(PG8_SA(0, 0), a2, voffA);
            PG8_WAIT_V(8); PG8_WAIT_L(0); PG8_BAR; PG8_MMA(1, 0, At, B0); PG8_MMA(1, 1, At, B1); PG8_BAR; PG8_SCHED;
            PG8_LDB(B0, 1, 0); PG8_LDB(B1, 1, 1); PG8_SCHED; PG8_LDA(At, 1, 0); PG8_STAGE(PG8_SA(0, 1), a2 + hstep, voffA);
            PG8_WAIT_V(8); PG8_WAIT_L(0); PG8_BAR; PG8_MMA(0, 0, At, B0); PG8_MMA(0, 1, At, B1); PG8_BAR; PG8_SCHED;
            PG8_LDA(At, 1, 1); PG8_STAGE(PG8_SB(1, 0), b3, voffB); PG8_STAGE(PG8_SB(1, 1), b3 + hstep, voffB); PG8_STAGE(PG8_SA(1, 0), a3, voffA);
            PG8_WAIT_V(8); PG8_WAIT_L(0); PG8_BAR; PG8_MMA(1, 0, At, B0); PG8_MMA(1, 1, At, B1); PG8_BAR; PG8_SCHED;
            } else {
            PG8_LDB(B0, 0, 0); PG8_SCHED; PG8_LDA(At, 0, 0); PG8_STAGE(PG8_SA(1, 1), a1 + hstep, voffA);
            PG8_WAIT_L(8); PG8_BAR; PG8_WAIT_L(0); PG8_MMA(0, 0, At, B0); PG8_BAR; PG8_SCHED;
            PG8_LDB(B1, 0, 1); PG8_STAGE(PG8_SB(0, 0), b2, voffB);
            PG8_BAR; PG8_WAIT_L(0); PG8_MMA(0, 1, At, B1); PG8_BAR;
            PG8_LDA(At, 0, 1); PG8_STAGE(PG8_SA(0, 0), a2, voffA);
            PG8_BAR; PG8_WAIT_L(0); PG8_MMA(1, 0, At, B0); PG8_BAR; PG8_SCHED;
            PG8_STAGE(PG8_SB(0, 1), b2 + hstep, voffB);
            PG8_WAIT_V(6); PG8_BAR; PG8_MMA(1, 1, At, B1); PG8_BAR;
            PG8_LDB(B0, 1, 0); PG8_SCHED; PG8_LDA(At, 1, 0); PG8_STAGE(PG8_SA(0, 1), a2 + hstep, voffA);
            PG8_WAIT_L(8); PG8_BAR; PG8_WAIT_L(0); PG8_MMA(0, 0, At, B0); PG8_BAR; PG8_SCHED;
            PG8_LDB(B1, 1, 1); PG8_STAGE(PG8_SB(1, 0), b3, voffB);
            PG8_BAR; PG8_WAIT_L(0); PG8_MMA(0, 1, At, B1); PG8_BAR;
            PG8_LDA(At, 1, 1); PG8_STAGE(PG8_SA(1, 0), a3, voffA);
            PG8_BAR; PG8_WAIT_L(0); PG8_MMA(1, 0, At, B0); PG8_BAR; PG8_SCHED;
            PG8_STAGE(PG8_SB(1, 1), b3 + hstep, voffB);
            PG8_WAIT_V(6); PG8_BAR; PG8_MMA(1, 1, At, B1); PG8_BAR;
            }
        }
        if constexpr (ALIGN_EPI) { if (wr == 0) PG8_BAR; }
        if constexpr (!Epi::AFTER_DRAIN) { E(acc, cur, wr, wc, fr, fq); S.done(cur); }
        if (!has_next) break;
#pragma unroll
        for (int a = 0; a < 2; ++a)
#pragma unroll
            for (int b = 0; b < 2; ++b)
#pragma unroll
                for (int m = 0; m < 4; ++m)
#pragma unroll
                    for (int n = 0; n < 2; ++n) acc[a][b][m][n] = (f32x4){0.f, 0.f, 0.f, 0.f};
        cur = nxt; cA = nA; cB = nB; ++ui;
        if constexpr (ALIGN_EPI) { if (wr == 1) PG8_BAR; }
    }
    PG8_WAIT_V(0);
    if constexpr (!ALIGN_EPI) { if (wr == 0) PG8_BAR; }
    PG8_BAR;
    if constexpr (Epi::AFTER_DRAIN) { E.fused(acc, cur, wr, wc, fr, fq, lds, wid, lane); S.done(cur); }
#undef PG8_SA
#undef PG8_SB
#undef PG8_STAGE
#undef PG8_LDA
#undef PG8_LDB
#undef PG8_MMA
#undef PG8_WAIT_V
#undef PG8_WAIT_L
#undef PG8_BAR
#undef PG8_SCHED
}
}

namespace sk {
using pg8::bf16_t; using pg8::bf16x8; using pg8::f32x4; using pg8::u32x4;
typedef unsigned u32x2 __attribute__((ext_vector_type(2)));
__device__ __forceinline__ u32x2 pack4(const f32x4& a) { u32x2 w; w.x = pg8::cvt_pk_bf16(a[0], a[1]); w.y = pg8::cvt_pk_bf16(a[2], a[3]); return w; }
__device__ __forceinline__ f32x4 un4(const u32x2& w) { return (f32x4){__builtin_bit_cast(float, w.x << 16), __builtin_bit_cast(float, w.x & 0xffff0000u), __builtin_bit_cast(float, w.y << 16), __builtin_bit_cast(float, w.y & 0xffff0000u)}; }
struct EpiUZ { bf16_t* Ub; bf16_t* SZ; const float* rs;
    __device__ __forceinline__ void operator()(int row, int ct, int w, int fq, f32x4 v0, f32x4 v1) const {
        const float s = rs[row]; const bool isz = ct >= 8; bf16_t* p = (isz ? SZ : Ub) + (size_t)row * 2048 + (ct & 7) * 256 + 16 * w + 4 * fq;
        v0 = v0 * s; v1 = v1 * s; if (isz) { v0 = pg8::silu4(v0); v1 = pg8::silu4(v1); }
        *(u32x2*)p = pack4(v0); *(u32x2*)(p + 128) = pack4(v1); } };
struct EpiGlu { const bf16_t* Yg; const bf16_t* SZ; bf16_t* Ob;
    __device__ __forceinline__ void operator()(int row, int ct, int w, int fq, f32x4 v0, f32x4 v1) const {
        const size_t off = (size_t)row * 2048 + ct * 256 + 16 * w + 4 * fq;
        const u32x2 y0 = *(const u32x2*)(Yg + off), y1 = *(const u32x2*)(Yg + off + 128), z0 = *(const u32x2*)(SZ + off), z1 = *(const u32x2*)(SZ + off + 128);
        *(u32x2*)(Ob + off) = pack4(un4(y0) * pg8::sigm4(v0) * un4(z0)); *(u32x2*)(Ob + off + 128) = pack4(un4(y1) * pg8::sigm4(v1) * un4(z1)); } };
struct EpiRes { const float* base; float* X; bf16_t* Xb; float* ssq;
    __device__ __forceinline__ void operator()(int row, int ct, int w, int fq, f32x4 v0, f32x4 v1) const {
        const size_t off = (size_t)row * 2048 + ct * 256 + 16 * w + 4 * fq;
        v0 += *(const f32x4*)(base + off); v1 += *(const f32x4*)(base + off + 128);
        *(f32x4*)(X + off) = v0; *(f32x4*)(X + off + 128) = v1;
        if (Xb) { *(u32x2*)(Xb + off) = pack4(v0); *(u32x2*)(Xb + off + 128) = pack4(v1); }
        float q = (v0[0] * v0[0] + v0[1] * v0[1]) + (v0[2] * v0[2] + v0[3] * v0[3]) + (v1[0] * v1[0] + v1[1] * v1[1]) + (v1[2] * v1[2] + v1[3] * v1[3]);
        q += __shfl_xor(q, 16); q += __shfl_xor(q, 32);
        if (fq == 0) atomicAdd(ssq + (size_t)row * NSSQ + ct * 4 + (w >> 1), q); } };
struct EpiKVQZ { const float* ssq; const float* rope; float* out; bf16_t* Kb; bf16_t* Vb; bf16_t* Qb; bf16_t* SZ2;
    __device__ __forceinline__ void operator()(int row, int ct, int w, int fq, f32x4 a, f32x4 b) const {
        const int kind = ct >> 3, f0 = 16 * (w & 3) + 4 * fq; const size_t off = (size_t)row * 2048 + (ct & 7) * 256 + (w >> 2) * 128 + f0;
        const f32x4 p0 = *(const f32x4*)(ssq + (size_t)row * NSSQ + 8 * fq), p1 = *(const f32x4*)(ssq + (size_t)row * NSSQ + 8 * fq + 4);
        float q = (p0[0] + p0[1]) + (p0[2] + p0[3]) + (p1[0] + p1[1]) + (p1[2] + p1[3]); q += __shfl_xor(q, 16); q += __shfl_xor(q, 32);
        const float rs = 1.0f / sqrtf(q * (1.0f / 2048.0f) + EPS);
        a = a * rs; b = b * rs;
        if (kind == 0 || kind == 2) { const int pos = PAST + ((row - MP) & 15); const float* cp = rope + (size_t)pos * 64 + f0;
            const f32x4 c = *(const f32x4*)cp, s = *(const f32x4*)(cp + (size_t)SEQ * 64); const f32x4 y = a * c - b * s, z = a * s + b * c; a = y; b = z; }
        const size_t oo = off - (size_t)MP * 2048;
        if (kind == 0) { *(f32x4*)(out + O_KS + oo) = a; *(f32x4*)(out + O_KS + oo + 64) = b; *(u32x2*)(Kb + off) = pack4(a); *(u32x2*)(Kb + off + 64) = pack4(b); }
        else if (kind == 1) { *(f32x4*)(out + O_VS + oo) = a; *(f32x4*)(out + O_VS + oo + 64) = b; *(u32x2*)(Vb + off) = pack4(a); *(u32x2*)(Vb + off + 64) = pack4(b); }
        else if (kind == 2) { *(u32x2*)(Qb + off) = pack4(a * QSCALE); *(u32x2*)(Qb + off + 64) = pack4(b * QSCALE); }
        else { *(u32x2*)(SZ2 + off) = pack4(pg8::silu4(a)); *(u32x2*)(SZ2 + off + 64) = pack4(pg8::silu4(b)); } } };
template <int N_> __device__ __forceinline__ void sk_wait() {
#define SK_W(n) else if constexpr (N_ == n) asm volatile("s_waitcnt vmcnt(" #n ")" ::: "memory");
    if constexpr (N_ == 0) asm volatile("s_waitcnt vmcnt(0)" ::: "memory");
    SK_W(2) SK_W(3) SK_W(4) SK_W(6) SK_W(8)
    else static_assert(N_ == 0, "sk_wait: add the count");
#undef SK_W
}
template <int RBK, int CW, class Epi> __device__ __forceinline__ void phase(PG8_LAS unsigned char* lds, const bf16_t* A, const bf16_t* Bt, int N, const Epi& E, int vcu, int nwg) {
    constexpr int K = 2048, NT = K / 64, NCB = CW / 16, RBW = RBK * NCB / 8, NCQ = 128 / CW, NRG = DB / RBK;
    constexpr int NBP = 2 * CW / 8, NAP = 16 * RBK / 8, P = (NBP + NAP) / 8, A_OFF = NBP * 1024, SLOT = (NBP + NAP) * 1024, NS = 4;
    static_assert((NBP + NAP) % 8 == 0 && RBW >= 1 && NS * SLOT <= 131072, "skinny item shape");
    const int tid = threadIdx.x, w = __builtin_amdgcn_readfirstlane(tid >> 6), lane = tid & 63, fr = lane & 15, fq = lane >> 4;
    const int nitems = NRG * (N / 256) * NCQ, cbp = w % NCB, rsub = w / NCB;
    const int rd0 = fr * 128 + ((fq ^ (fr & 7)) * 16), rd1 = fr * 128 + (((4 + fq) ^ (fr & 7)) * 16);
    for (int it = vcu; it < nitems; it += nwg) {
        const int rg = it % NRG, ccol = it / NRG, ct = ccol / NCQ, cq = ccol % NCQ, r0 = MP + 16 * RBK * rg;
        const char* src[P]; unsigned dst[P];
#pragma unroll
        for (int j = 0; j < P; ++j) { const int gp = w * P + j; const bool isb = gp < NBP; const int p = isb ? gp : gp - NBP, row = 8 * p + (lane >> 3), cl = (lane & 7) ^ (row & 7);
            const size_t grow = isb ? (size_t)(ct * 256 + (row < CW ? cq * CW + row : 128 + cq * CW + (row - CW))) : (size_t)(r0 + row);
            src[j] = (const char*)((isb ? Bt : A) + grow * K) + cl * 16; dst[j] = (unsigned)((isb ? 0 : A_OFF) + p * 1024); }
#define SK_STAGE(s, t) do { _Pragma("unroll") for (int j_ = 0; j_ < P; ++j_) \
            __builtin_amdgcn_global_load_lds((const unsigned*)(src[j_] + (size_t)(t) * 128), (PG8_LAS unsigned*)(lds + (s) * SLOT + __builtin_amdgcn_readfirstlane((int)dst[j_])), 16, 0, 0); } while (0)
        f32x4 acc[RBW][2];
#pragma unroll
        for (int i = 0; i < RBW; ++i) { acc[i][0] = (f32x4){0.f, 0.f, 0.f, 0.f}; acc[i][1] = (f32x4){0.f, 0.f, 0.f, 0.f}; }
        SK_STAGE(0, 0); SK_STAGE(1, 1); SK_STAGE(2, 2);
        for (int t4 = 0; t4 < NT / 4; ++t4) {
#define SK_STEP(u) do { const int t = 4 * t4 + (u); \
            if (t + 2 < NT) sk_wait<2 * P>(); else if (t + 1 < NT) sk_wait<P>(); else sk_wait<0>();       \
            asm volatile("s_waitcnt lgkmcnt(0)" ::: "memory"); __builtin_amdgcn_s_barrier(); asm volatile("" ::: "memory"); \
            if (t + 3 < NT) SK_STAGE(((u) + 3) & 3, t + 3);                                              \
            bf16x8 af[RBW][2]; \
            _Pragma("unroll") for (int i_ = 0; i_ < RBW; ++i_) { const int ab_ = (u) * SLOT + A_OFF + (rsub * RBW + i_) * 2048; af[i_][0] = *(const PG8_LAS bf16x8*)(lds + ab_ + rd0); af[i_][1] = *(const PG8_LAS bf16x8*)(lds + ab_ + rd1); } \
            _Pragma("unroll") for (int h_ = 0; h_ < 2; ++h_) { const int bb_ = (u) * SLOT + (h_ * CW + 16 * cbp) * 128; \
                const bf16x8 b0_ = *(const PG8_LAS bf16x8*)(lds + bb_ + rd0), b1_ = *(const PG8_LAS bf16x8*)(lds + bb_ + rd1); \
                _Pragma("unroll") for (int i_ = 0; i_ < RBW; ++i_) { acc[i_][h_] = __builtin_amdgcn_mfma_f32_16x16x32_bf16(b0_, af[i_][0], acc[i_][h_], 0, 0, 0); \
                    acc[i_][h_] = __builtin_amdgcn_mfma_f32_16x16x32_bf16(b1_, af[i_][1], acc[i_][h_], 0, 0, 0); } } } while (0)
            SK_STEP(0); SK_STEP(1); SK_STEP(2); SK_STEP(3);
#undef SK_STEP
        }
        asm volatile("s_waitcnt vmcnt(0) lgkmcnt(0)" ::: "memory"); __builtin_amdgcn_s_barrier(); asm volatile("" ::: "memory");
#pragma unroll
        for (int i = 0; i < RBW; ++i) E(r0 + 16 * (rsub * RBW + i) + fr, ct, cq * NCB + cbp, fq, acc[i][0], acc[i][1]);
#undef SK_STAGE
    }
}
}

constexpr int NWAVES = 8;
constexpr int RING_OFF = 0, RING_BYTES = 131072;
constexpr int LDSCTL_OFF = RING_BYTES, MISC_OFF = LDSCTL_OFF + 320;
constexpr int LDS_BYTES = 155648;
static_assert(MISC_OFF + 128 <= LDS_BYTES, "LDS map");

#define GAS __attribute__((address_space(1)))
#define LAS __attribute__((address_space(3)))
typedef GAS unsigned gu32;
#define RLX_AGENT __ATOMIC_RELAXED, __HIP_MEMORY_SCOPE_AGENT
#define LDS_WAIT() asm volatile("s_waitcnt lgkmcnt(0)" ::: "memory")
#define VM_WAIT() asm volatile("s_waitcnt vmcnt(0)" ::: "memory")
#define XB_TMO      128
#define XB_XCNT(j)  (256  + 64 * (j))
#define XB_XSUB(j)  (1280 + 64 * (j))
#define XB_XGEN(j)  (2304 + 64 * (j))
#define XB_TOP      3328
#define XB_TOPGEN   3392
#define XCD_BAR_WORDS 3456
#define XB_SPIN_CAP (1u << 18)

__device__ __forceinline__ unsigned xb_ld(unsigned* p)              { return __hip_atomic_load(p, __ATOMIC_RELAXED, __HIP_MEMORY_SCOPE_AGENT); }
__device__ __forceinline__ unsigned xb_add(unsigned* p, unsigned v) { return __hip_atomic_fetch_add(p, v, __ATOMIC_RELAXED, __HIP_MEMORY_SCOPE_AGENT); }
__device__ __forceinline__ unsigned xb_xcc_id() { return (unsigned)__builtin_amdgcn_s_getreg((3 << 11) | 20) & 0xFu; }
#define XB_SPIN(cond, bar) do { unsigned _sp = 0; while (cond) { __builtin_amdgcn_s_sleep(1); \
    if ((++_sp & 255u) == 0u) { if (xb_ld(&(bar)[XB_TMO])) break; if (_sp > XB_SPIN_CAP) { atomicAdd(&(bar)[XB_TMO], 1u); break; } } } } while (0)

struct XcdBarrier {
    unsigned* bar; unsigned x;
    volatile LAS unsigned* st;
};

__device__ __forceinline__ XcdBarrier xcd_barrier_post(unsigned* bar, volatile LAS unsigned* st) {
    XcdBarrier b; b.bar = bar; b.x = xb_xcc_id(); b.st = st;
    if (threadIdx.x == 0) (void)xb_add(&bar[XB_XCNT(b.x)], 1u);
    return b;
}
__device__ __forceinline__ void xcd_barrier_complete(unsigned* bar, unsigned x, unsigned& nloc, unsigned& nx) {
    const unsigned G = gridDim.x * gridDim.y * gridDim.z;
    unsigned sum, cnt, mine, sp = 0u;
    for (;;) {
        sum = 0u; cnt = 0u; mine = 0u;
#pragma unroll
        for (unsigned j = 0; j < 16; ++j) { const unsigned c = xb_ld(&bar[XB_XCNT(j)]); sum += c; cnt += (c > 0u) ? 1u : 0u; mine = (j == x) ? c : mine; }
        if (sum == G) break;
        __builtin_amdgcn_s_sleep(1);
        if ((++sp & 255u) == 0u) { if (xb_ld(&bar[XB_TMO])) break; if (sp > XB_SPIN_CAP) { atomicAdd(&bar[XB_TMO], 1u); break; } }
    }
    nloc = mine > 0u ? mine : 1u; nx = cnt > 0u ? cnt : 1u;
}

__device__ __forceinline__ void xcd_barrier(const XcdBarrier& b) {
    asm volatile("s_waitcnt vmcnt(0)" ::: "memory");
    __syncthreads();
    if (threadIdx.x == 0) {
        unsigned* bar = b.bar;
        __builtin_amdgcn_s_waitcnt(0);
        unsigned nloc = b.st[0], nx = b.st[1];
        if (nloc == 0u) { xcd_barrier_complete(bar, b.x, nloc, nx); b.st[0] = nloc; b.st[1] = nx; }
        const unsigned old = xb_add(&bar[XB_XSUB(b.x)], 1u);
        const unsigned gen = old / nloc;
        if (old + 1u == (gen + 1u) * nloc) {
            __builtin_amdgcn_fence(__ATOMIC_RELEASE, "agent");
            asm volatile("s_waitcnt vmcnt(0)" ::: "memory");
            const unsigned og = xb_add(&bar[XB_TOP], 1u);
            const unsigned tg = og / nx;
            if (og + 1u == (tg + 1u) * nx) xb_add(&bar[XB_TOPGEN], 1u);
            else XB_SPIN(xb_ld(&bar[XB_TOPGEN]) == tg, bar);
            __builtin_amdgcn_fence(__ATOMIC_ACQUIRE, "agent");
            xb_add(&bar[XB_XGEN(b.x)], 1u);
            asm volatile("s_waitcnt vmcnt(0)" ::: "memory");
        } else {
            XB_SPIN(xb_ld(&bar[XB_XGEN(b.x)]) == gen, bar);
            __builtin_amdgcn_fence(__ATOMIC_ACQUIRE, "agent");
            asm volatile("s_waitcnt vmcnt(0)" ::: "memory");
        }
    }
    __syncthreads();
}

struct Frame {
    LAS unsigned char* lds;
    volatile LAS unsigned* MISC;
    gu32* ctl;
    int tid, lane, wave;
    int vcu, G;
};
struct Args { const float* in[29]; float* out; unsigned char* ws; int ph_lo, ph_hi, li, pad; };


constexpr size_t WS_MF = 768 * MiB;
constexpr size_t WS_EG = 800 * MiB;
constexpr size_t WS_A16 = 2 * MiB;
constexpr size_t WS_END2 = 816 * MiB;
static_assert(WS_END <= WS_MF, "ws map");

__device__ __forceinline__ void p0_ssm_item(const Args& a, int g, int t, LAS float* scr, int lane) {
    unsigned char* ws = a.ws;
    bf16_t* MFg = (bf16_t*)(ws + WS_MF) + (size_t)g * 256 * 384; bf16_t* Eg = (bf16_t*)(ws + WS_EG) + (size_t)g * 128 * 256; float* A16 = (float*)(ws + WS_A16) + (size_t)g * 128;
    const int p = lane, gp = g * NP + p;
    const double lr = a.in[8][gp], li = a.in[9][gp], dt = exp((double)a.in[10][g]);
    const double zr = lr * dt, zi = li * dt, mag = exp(zr), ar = mag * cos(zi), ai = mag * sin(zi);
    const double nr = ar - 1.0, ni = ai, den = lr * lr + li * li;
    const double cfr = (nr * lr + ni * li) / den, cfi = (ni * lr - nr * li) / den;
    double pr = 1.0, pi = 0.0;
    for (int k = 0; k < t; ++k) { const double x = pr * ar - pi * ai, y = pr * ai + pi * ar; pr = x; pi = y; }
    const double qr = pr * ar - pi * ai, qi = pr * ai + pi * ar;
    u32x4 er[2], ei[2];
#pragma unroll
    for (int c2 = 0; c2 < 8; ++c2) { float wr[2], wi[2];
#pragma unroll
        for (int e = 0; e < 2; ++e) { const int c = 2 * c2 + e; const double br = a.in[11][(size_t)gp * GC + c], bi = a.in[12][(size_t)gp * GC + c];
            const double bbr = cfr * br - cfi * bi, bbi = cfr * bi + cfi * br;
            wr[e] = (float)(pr * bbr - pi * bbi); wi[e] = (float)(pr * bbi + pi * bbr);
            scr[p * 16 + c] = wr[e]; scr[1024 + p * 16 + c] = wi[e]; }
        er[c2 >> 2][c2 & 3] = pk2(wr[0], wr[1]); ei[c2 >> 2][c2 & 3] = pk2(wi[0], wi[1]); }
    { const int j = 15 - t; bf16_t* e0 = Eg + (size_t)p * 256 + 16 * j; bf16_t* e1 = Eg + (size_t)(64 + p) * 256 + 16 * j;
      *(u32x4*)e0 = er[0]; *(u32x4*)(e0 + 8) = er[1]; *(u32x4*)e1 = ei[0]; *(u32x4*)(e1 + 8) = ei[1]; }
    const float fqr = (float)qr, fqi = (float)qi;
#pragma unroll
    for (int c = 0; c < GC; ++c) { const float cr = a.in[13][((size_t)g * GC + c) * NP + p], ci = a.in[14][((size_t)g * GC + c) * NP + p];
        scr[2048 + c * 64 + p] = cr; scr[3072 + c * 64 + p] = ci;
        bf16_t* fr_ = MFg + (size_t)(16 * t + c) * 384 + 256 + p;
        fr_[0] = (bf16_t)f2bf(cr * fqr - ci * fqi); fr_[64] = (bf16_t)f2bf(-(cr * fqi + ci * fqr)); }
    if (t == 15) { A16[p] = fqr; A16[64 + p] = fqi; }
    LDS_WAIT(); asm volatile("" ::: "memory");
    const int c = lane >> 2, c0 = (lane & 3) * 4; f32x4 acc = (f32x4){0.f, 0.f, 0.f, 0.f};
    for (int q = 0; q < NP; ++q) { const float cr = scr[2048 + c * 64 + q], ci = scr[3072 + c * 64 + q];
        const f32x4 wr = *(const LAS f32x4*)(scr + q * 16 + c0), wi = *(const LAS f32x4*)(scr + 1024 + q * 16 + c0);
        acc += wr * cr - wi * ci; }
    u32x2 kv; kv.x = pk2(acc[0], acc[1]); kv.y = pk2(acc[2], acc[3]);
    for (int i = t; i < 16; ++i) *(u32x2*)(MFg + (size_t)(16 * i + c) * 384 + 16 * (i - t) + c0) = kv;
    if (t >= 1) for (int i = 0; i + t < 16; ++i) *(u32x2*)(MFg + (size_t)(16 * i + c) * 384 + 16 * (i + t) + c0) = (u32x2){0u, 0u};
    LDS_WAIT(); asm volatile("" ::: "memory");
}

constexpr int SSM_UST = 264, SSM_HST = 136;
constexpr int SSM_U_OFF = 0, SSM_H_OFF = SSM_U_OFF + 32 * SSM_UST * 2, SSM_S_OFF = SSM_H_OFF + 32 * SSM_HST * 2, SSM_LDS_END = SSM_S_OFF + 128 * 33 * 4;
static_assert(SSM_LDS_END <= RING_BYTES, "ssm lds");
__device__ __forceinline__ float gelu_fast(float x) { const float t = 1.5957691216057308f * (x + 0.044715f * x * x * x); return x * __builtin_amdgcn_rcpf(1.f + __builtin_amdgcn_exp2f(-1.4426950408889634f * t)); }

__device__ __forceinline__ void p2_ssm(Frame& F, const Args& a) {
    const int g = F.vcu >> 1, hf = F.vcu & 1; if (g >= NG) return;
    unsigned char* ws = a.ws;
    const bf16_t* MFg = (const bf16_t*)(ws + WS_MF) + (size_t)g * 256 * 384; const bf16_t* Eg = (const bf16_t*)(ws + WS_EG) + (size_t)g * 128 * 256; const float* A16 = (const float*)(ws + WS_A16) + (size_t)g * 128;
    const bf16_t* Ub = (const bf16_t*)(ws + WS_UB); bf16_t* Yg = (bf16_t*)(ws + WS_YG);
    const int w = F.wave, lane = F.lane, fr = lane & 15, fq = lane >> 4, tid = F.tid;
    const int iw = w < 4 ? w : 11 - w, ti = 2 * iw + hf;
    LAS bf16_t* Ul = (LAS bf16_t*)(F.lds + SSM_U_OFF); LAS bf16_t* Hl = (LAS bf16_t*)(F.lds + SSM_H_OFF); LAS float* Sl = (LAS float*)(F.lds + SSM_S_OFF);
    bf16x8 mf[12], ef[8];
#pragma unroll
    for (int ks = 0; ks < 12; ++ks) mf[ks] = *(const bf16x8*)(MFg + (size_t)(16 * ti + fr) * 384 + 32 * ks + 8 * fq);
#pragma unroll
    for (int ks = 0; ks < 8; ++ks) ef[ks] = *(const bf16x8*)(Eg + (size_t)(16 * w + fr) * 256 + 32 * ks + 8 * fq);
    float a16r = 0.f, a16i = 0.f, hr = 0.f, hi = 0.f;
    if (w == 0) { a16r = A16[lane]; a16i = A16[64 + lane]; }
    f32x4 dsk = *(const f32x4*)(a.in[15] + g * GC + 4 * fq);
    u32x4 u0 = *(const u32x4*)(Ub + (size_t)tid * DM + g * GC), u1 = *(const u32x4*)(Ub + (size_t)tid * DM + g * GC + 8);
    for (int blk = 0; blk < 17; ++blk) {
        { LAS bf16_t* d = Ul + (tid >> 4) * SSM_UST + (tid & 15) * 16; *(LAS u32x4*)d = u0; *(LAS u32x4*)(d + 8) = u1; }
        __syncthreads();
        if (blk + 1 < 17) { const bf16_t* s = Ub + (size_t)(512 * (blk + 1) + tid) * DM + g * GC; u0 = *(const u32x4*)s; u1 = *(const u32x4*)(s + 8); }
#pragma unroll
        for (int nb = 0; nb < 2; ++nb) { f32x4 s = (f32x4){0.f, 0.f, 0.f, 0.f};
            bf16x8 ub[8];
#pragma unroll
            for (int ks = 0; ks < 8; ++ks) ub[ks] = *(const LAS bf16x8*)(Ul + (16 * nb + fr) * SSM_UST + 32 * ks + 8 * fq);
#pragma unroll
            for (int ks = 0; ks < 8; ++ks) s = __builtin_amdgcn_mfma_f32_16x16x32_bf16(ef[ks], ub[ks], s, 0, 0, 0);
#pragma unroll
            for (int r = 0; r < 4; ++r) Sl[(16 * w + 4 * fq + r) * 33 + 16 * nb + fr] = s[r]; }
        __syncthreads();
        if (w == 0) {
            float sr[32], si[32];
#pragma unroll
            for (int c = 0; c < 32; ++c) { sr[c] = Sl[lane * 33 + c]; si[c] = Sl[(64 + lane) * 33 + c]; }
            if (blk < 16) {
#pragma unroll
                for (int c = 0; c < 32; ++c) { Hl[c * SSM_HST + lane] = (bf16_t)f2bf(hr); Hl[c * SSM_HST + 64 + lane] = (bf16_t)f2bf(hi);
                    const float nr = a16r * hr - a16i * hi + sr[c], ni = a16r * hi + a16i * hr + si[c]; hr = nr; hi = ni; }
                if (blk == 15 && hf == 0) { a.out[O_REP + g * NP + lane] = hr; a.out[O_IMP + g * NP + lane] = hi; }
            } else {
#pragma unroll 4
                for (int b = 0; b < 32; ++b) { const float h0r = a.in[2][((size_t)b * NG + g) * NP + lane], h0i = a.in[3][((size_t)b * NG + g) * NP + lane];
                    Hl[b * SSM_HST + lane] = (bf16_t)f2bf(h0r); Hl[b * SSM_HST + 64 + lane] = (bf16_t)f2bf(h0i);
                    if (hf == 0) { a.out[O_RES + ((size_t)b * NG + g) * NP + lane] = a16r * h0r - a16i * h0i + sr[b]; a.out[O_IMS + ((size_t)b * NG + g) * NP + lane] = a16r * h0i + a16i * h0r + si[b]; } }
            }
        }
        __syncthreads();
#pragma unroll
        for (int nb = 0; nb < 2; ++nb) {
            bf16x8 hb[4], ub[8];
#pragma unroll
            for (int ks = 0; ks < 8; ++ks) ub[ks] = *(const LAS bf16x8*)(Ul + (16 * nb + fr) * SSM_UST + 32 * ks + 8 * fq);
#pragma unroll
            for (int kk = 0; kk < 4; ++kk) hb[kk] = *(const LAS bf16x8*)(Hl + (16 * nb + fr) * SSM_HST + 32 * kk + 8 * fq);
            f32x4 y = (f32x4){0.f, 0.f, 0.f, 0.f};
#pragma unroll
            for (int ks = 0; ks < 8; ++ks) if (ks <= iw) y = __builtin_amdgcn_mfma_f32_16x16x32_bf16(mf[ks], ub[ks], y, 0, 0, 0);
#pragma unroll
            for (int kk = 0; kk < 4; ++kk) y = __builtin_amdgcn_mfma_f32_16x16x32_bf16(mf[8 + kk], hb[kk], y, 0, 0, 0);
            const int ch = 16 * nb + fr;
            const u32x2 uu = *(const LAS u32x2*)(Ul + ch * SSM_UST + 16 * ti + 4 * fq);
            const f32x4 uf = (f32x4){bflo(uu.x), bfhi(uu.x), bflo(uu.y), bfhi(uu.y)};
            y += dsk * uf;
            u32x2 o; o.x = pk2(gelu_fast(y[0]), gelu_fast(y[1])); o.y = pk2(gelu_fast(y[2]), gelu_fast(y[3]));
            *(u32x2*)(Yg + (size_t)(512 * blk + 16 * ch + ti) * DM + g * GC + 4 * fq) = o;
        }
        __syncthreads();
    }
}

namespace att {
typedef float f32x8 __attribute__((ext_vector_type(8)));
typedef short s16x4 __attribute__((ext_vector_type(4)));
constexpr float THR = 8.f;
constexpr int KIMG = 16384, KSLOT = 2 * KIMG, VSLOT = 32768, V_OFF = 2 * KSLOT;
constexpr int Q_OFF = 131072 + 1024;
constexpr int OFFS_OFF = 131072 + 2048;
static_assert(OFFS_OFF + 512 * 32 <= LDS_BYTES, "attention LDS map");
typedef float f32x2_t __attribute__((ext_vector_type(2))); typedef __bf16 bf16x2_t __attribute__((ext_vector_type(2)));
__device__ __forceinline__ unsigned cvtpk(float lo, float hi) { f32x2_t v = {lo, hi}; bf16x2_t b = __builtin_convertvector(v, bf16x2_t); return __builtin_bit_cast(unsigned, b); }
__device__ __forceinline__ bf16x8 tobf(const f32x8& x) { u32x4 w = {cvtpk(x[0], x[1]), cvtpk(x[2], x[3]), cvtpk(x[4], x[5]), cvtpk(x[6], x[7])}; return __builtin_bit_cast(bf16x8, w); }
__device__ __forceinline__ int fK(int row) { return (((row >> 3) & 3) << 2) | (row & 3); }
__device__ __forceinline__ int xV(int row) { return (((row >> 3) & 3) << 3) | ((row & 3) << 1); }
__device__ __forceinline__ int k_st(int row, int c) { return row * 256 + 16 * (c ^ fK(row)); }
__device__ __forceinline__ int v_st(int row, int c) { return row * 512 + 16 * (c ^ xV(row)); }
__device__ __forceinline__ float grp_max(float v) {
    { auto rr = __builtin_amdgcn_permlane16_swap(__float_as_uint(v), __float_as_uint(v), false, false); v = fmaxf(__uint_as_float(rr[0]), __uint_as_float(rr[1])); }
    { auto rr = __builtin_amdgcn_permlane32_swap(__float_as_uint(v), __float_as_uint(v), false, false); v = fmaxf(__uint_as_float(rr[0]), __uint_as_float(rr[1])); }
    return v;
}
__device__ __forceinline__ float grp_sum(float v) {
    { auto rr = __builtin_amdgcn_permlane16_swap(__float_as_uint(v), __float_as_uint(v), false, false); v = __uint_as_float(rr[0]) + __uint_as_float(rr[1]); }
    { auto rr = __builtin_amdgcn_permlane32_swap(__float_as_uint(v), __float_as_uint(v), false, false); v = __uint_as_float(rr[0]) + __uint_as_float(rr[1]); }
    return v;
}
struct Rd { int ka[4]; int vb; int vk; };
__device__ __forceinline__ void make_rd(Rd& R, int lane) {
    const int i = lane & 15, dq = lane >> 4;
#pragma unroll
    for (int ds = 0; ds < 4; ++ds) R.ka[ds] = (8 * (i >> 2) + (i & 3)) * 256 + 16 * (dq ^ (i & 3)) + 64 * (ds ^ (i >> 2));
    const int g = lane >> 4, q = (lane & 15) >> 2, p = lane & 3;
    R.vb = (8 * g + q) * 512 + 16 * (p >> 1) + 8 * (p & 1); R.vk = 4 * g + q;
}
__device__ __forceinline__ void scores(f32x4 (&s)[4], const LAS unsigned char* Kimg, const Rd& R, const bf16x8 (&q16)[4], float m_ref) {
#pragma unroll
    for (int kb = 0; kb < 4; ++kb) s[kb] = (f32x4){-m_ref, -m_ref, -m_ref, -m_ref};
#pragma unroll
    for (int ds = 0; ds < 4; ++ds)
#pragma unroll
        for (int kb = 0; kb < 4; ++kb) { const bf16x8 kf = *(const LAS bf16x8*)(Kimg + R.ka[ds] + (32 * (kb >> 1) + 4 * (kb & 1)) * 256);
            s[kb] = __builtin_amdgcn_mfma_f32_16x16x32_bf16(kf, q16[ds], s[kb], 0, 0, 0); }
}
__device__ __forceinline__ float max3f(float a, float b, float c) { return fmaxf(fmaxf(a, b), c); }
__device__ __forceinline__ void softmax(f32x4 (&s)[4], float& m_reg, float& l_reg, float& alpha, bf16x8 (&pa)[2], bool first) {
    float pmax = fmaxf(max3f(max3f(s[0][0], s[0][1], s[0][2]), max3f(s[0][3], s[1][0], s[1][1]), max3f(s[1][2], s[1][3], s[2][0])),
                       max3f(max3f(s[2][1], s[2][2], s[2][3]), max3f(s[3][0], s[3][1], s[3][2]), s[3][3]));
    pmax = grp_max(pmax);
    if (__builtin_expect(!first && __all(pmax <= THR), 1)) { alpha = 1.f; }
    else { const float d = first ? pmax : fmaxf(pmax, 0.f); alpha = first ? 0.f : __builtin_amdgcn_exp2f(-d); m_reg += d;
#pragma unroll
        for (int kb = 0; kb < 4; ++kb) s[kb] -= d; }
    float ps = 0.f;
#pragma unroll
    for (int kb = 0; kb < 4; ++kb)
#pragma unroll
        for (int r = 0; r < 4; ++r) { s[kb][r] = __builtin_amdgcn_exp2f(s[kb][r]); ps += s[kb][r]; }
    ps = grp_sum(ps);
    l_reg = l_reg * alpha + ps;
#pragma unroll
    for (int st = 0; st < 2; ++st) { u32x4 w = {cvtpk(s[2 * st][0], s[2 * st][1]), cvtpk(s[2 * st][2], s[2 * st][3]), cvtpk(s[2 * st + 1][0], s[2 * st + 1][1]), cvtpk(s[2 * st + 1][2], s[2 * st + 1][3])};
        pa[st] = __builtin_bit_cast(bf16x8, w); }
}
template <int OFF> __device__ __forceinline__ s16x4 tr_read(int vb) { s16x4 r; asm volatile("ds_read_b64_tr_b16 %0, %1 offset:%2" : "=&v"(r) : "v"(vb), "i"(OFF) : "memory"); return r; }
#define VFR(lo, hi) (bf16x8){lo[0], lo[1], lo[2], lo[3], hi[0], hi[1], hi[2], hi[3]}
struct NoFill { __device__ __forceinline__ void operator()(int) const {} };
template <class Fill> __device__ __forceinline__ void pv2(f32x4 (&o1)[16], f32x4 (&o2)[16], int vbase, const Rd& R, const bf16x8 (&p1)[2], const bf16x8 (&p2)[2], const Fill& fill) {
    int vk = R.vk, vb = R.vb + vbase; asm volatile("" : "+v"(vk), "+v"(vb));
    s16x4 a0, a1, b0, b1, c0, c1, d0, d1;
    { const int v0 = vb + 32 * (0 ^ vk); a0 = tr_read<0>(v0); a1 = tr_read<4 * 512>(v0); b0 = tr_read<32 * 512>(v0); b1 = tr_read<36 * 512>(v0); }
#pragma unroll
    for (int cb = 0; cb < 16; cb += 2) {
        { const int v1 = vb + 32 * ((cb + 1) ^ vk); c0 = tr_read<0>(v1); c1 = tr_read<4 * 512>(v1); d0 = tr_read<32 * 512>(v1); d1 = tr_read<36 * 512>(v1); }
        asm volatile("s_waitcnt lgkmcnt(4)" : "+v"(a0), "+v"(a1), "+v"(b0), "+v"(b1) :: "memory"); __builtin_amdgcn_sched_barrier(0);
        { const bf16x8 fa = VFR(a0, a1), fb = VFR(b0, b1);
          o1[cb] = __builtin_amdgcn_mfma_f32_16x16x32_bf16(fa, p1[0], o1[cb], 0, 0, 0); o2[cb] = __builtin_amdgcn_mfma_f32_16x16x32_bf16(fa, p2[0], o2[cb], 0, 0, 0);
          o1[cb] = __builtin_amdgcn_mfma_f32_16x16x32_bf16(fb, p1[1], o1[cb], 0, 0, 0); o2[cb] = __builtin_amdgcn_mfma_f32_16x16x32_bf16(fb, p2[1], o2[cb], 0, 0, 0); }
        __builtin_amdgcn_sched_barrier(0);
        if (cb + 2 < 16) { const int v0 = vb + 32 * ((cb + 2) ^ vk); a0 = tr_read<0>(v0); a1 = tr_read<4 * 512>(v0); b0 = tr_read<32 * 512>(v0); b1 = tr_read<36 * 512>(v0);
            asm volatile("s_waitcnt lgkmcnt(4)" : "+v"(c0), "+v"(c1), "+v"(d0), "+v"(d1) :: "memory"); }
        else asm volatile("s_waitcnt lgkmcnt(0)" : "+v"(c0), "+v"(c1), "+v"(d0), "+v"(d1) :: "memory");
        __builtin_amdgcn_sched_barrier(0);
        { const bf16x8 fc = VFR(c0, c1), fd = VFR(d0, d1);
          o1[cb + 1] = __builtin_amdgcn_mfma_f32_16x16x32_bf16(fc, p1[0], o1[cb + 1], 0, 0, 0); o2[cb + 1] = __builtin_amdgcn_mfma_f32_16x16x32_bf16(fc, p2[0], o2[cb + 1], 0, 0, 0);
          o1[cb + 1] = __builtin_amdgcn_mfma_f32_16x16x32_bf16(fd, p1[1], o1[cb + 1], 0, 0, 0); o2[cb + 1] = __builtin_amdgcn_mfma_f32_16x16x32_bf16(fd, p2[1], o2[cb + 1], 0, 0, 0); }
        fill(cb >> 1);
        __builtin_amdgcn_sched_barrier(0);
    }
}
__device__ __forceinline__ void pv1(f32x4 (&o)[16], int vbase, const Rd& R, const bf16x8 (&p)[2]) {
    int vk = R.vk, vb = R.vb + vbase; asm volatile("" : "+v"(vk), "+v"(vb));
    s16x4 a0, a1, b0, b1, c0, c1, d0, d1;
    { const int v0 = vb + 32 * (0 ^ vk); a0 = tr_read<0>(v0); a1 = tr_read<4 * 512>(v0); b0 = tr_read<32 * 512>(v0); b1 = tr_read<36 * 512>(v0); }
#pragma unroll
    for (int cb = 0; cb < 16; cb += 2) {
        { const int v1 = vb + 32 * ((cb + 1) ^ vk); c0 = tr_read<0>(v1); c1 = tr_read<4 * 512>(v1); d0 = tr_read<32 * 512>(v1); d1 = tr_read<36 * 512>(v1); }
        asm volatile("s_waitcnt lgkmcnt(4)" : "+v"(a0), "+v"(a1), "+v"(b0), "+v"(b1) :: "memory"); __builtin_amdgcn_sched_barrier(0);
        o[cb] = __builtin_amdgcn_mfma_f32_16x16x32_bf16(VFR(a0, a1), p[0], o[cb], 0, 0, 0); o[cb] = __builtin_amdgcn_mfma_f32_16x16x32_bf16(VFR(b0, b1), p[1], o[cb], 0, 0, 0);
        __builtin_amdgcn_sched_barrier(0);
        if (cb + 2 < 16) { const int v0 = vb + 32 * ((cb + 2) ^ vk); a0 = tr_read<0>(v0); a1 = tr_read<4 * 512>(v0); b0 = tr_read<32 * 512>(v0); b1 = tr_read<36 * 512>(v0);
            asm volatile("s_waitcnt lgkmcnt(4)" : "+v"(c0), "+v"(c1), "+v"(d0), "+v"(d1) :: "memory"); }
        else asm volatile("s_waitcnt lgkmcnt(0)" : "+v"(c0), "+v"(c1), "+v"(d0), "+v"(d1) :: "memory");
        __builtin_amdgcn_sched_barrier(0);
        o[cb + 1] = __builtin_amdgcn_mfma_f32_16x16x32_bf16(VFR(c0, c1), p[0], o[cb + 1], 0, 0, 0); o[cb + 1] = __builtin_amdgcn_mfma_f32_16x16x32_bf16(VFR(d0, d1), p[1], o[cb + 1], 0, 0, 0);
        __builtin_amdgcn_sched_barrier(0);
    }
}
#undef VFR
struct Ctx { const bf16_t* Qb; const bf16_t* Kb; const bf16_t* Vb; const bf16_t* SZ2; bf16_t* Ab; const float* ck; const float* cv; const float* subln; float lam; };

__device__ __forceinline__ void finish_rows(const Ctx& C, f32x4 (&o1)[16], const f32x4 (&o2)[16], float l1, float l2, int row, int h, int lane) {
    int g = lane >> 4; asm volatile("" : "+v"(g));
    const float f1 = 1.f / l1, f2 = -C.lam / l2; float ss = 0.f;
#pragma unroll
    for (int cb = 0; cb < 16; ++cb) { o1[cb] = o1[cb] * f1 + o2[cb] * f2; ss += (o1[cb][0] * o1[cb][0] + o1[cb][1] * o1[cb][1]) + (o1[cb][2] * o1[cb][2] + o1[cb][3] * o1[cb][3]); }
    ss = grp_sum(ss);
    const float rr = (1.0f / sqrtf(ss * (1.0f / 256.0f) + EPS)) * (1.0f - LAMBDA_INIT);
    const size_t rowoff = (size_t)row * DM + h * 256 + 4 * g;
#pragma unroll
    for (int cb = 0; cb < 16; ++cb) { const f32x4 sg = *(const f32x4*)(C.subln + 16 * cb + 4 * g); const u32x2 z = *(const u32x2*)(C.SZ2 + rowoff + 16 * cb);
        u32x2 ov; ov.x = pk2(o1[cb][0] * rr * sg[0] * bflo(z.x), o1[cb][1] * rr * sg[1] * bfhi(z.x)); ov.y = pk2(o1[cb][2] * rr * sg[2] * bflo(z.y), o1[cb][3] * rr * sg[3] * bfhi(z.y));
        *(u32x2*)(C.Ab + rowoff + 16 * cb) = ov; }
}
__device__ __forceinline__ void glds16(const void* gsrc, unsigned lds_dst) { unsigned keep;
    asm volatile("s_mov_b32 %0, m0\n\ts_mov_b32 m0, %2\n\ts_nop 0\n\tglobal_load_lds_dwordx4 %1, off\n\ts_mov_b32 m0, %0" : "=&s"(keep) : "v"(gsrc), "s"(lds_dst) : "memory"); }
#define WAIT_BAR(N) asm volatile("s_waitcnt vmcnt(" #N ") lgkmcnt(0)\n\ts_barrier" ::: "memory")
#define RFL(x) ((unsigned)__builtin_amdgcn_readfirstlane((int)(x)))
#define ATT_SCALE(o, a) do { _Pragma("unroll") for (int cb_ = 0; cb_ < 16; ++cb_) o[cb_] *= (a); } while (0)

template <int MODE> __device__ __forceinline__ void prompt_unit(const Ctx& C, LAS unsigned char* lds, int c, int h, int tid) {
    const int w = __builtin_amdgcn_readfirstlane(tid >> 6), lane = tid & 63;
    Rd R; make_rd(R, lane);
    bf16x8 q1[4], q2[4];
    { const bf16_t* Qw = C.Qb + (size_t)(128 * c + 16 * w + (lane & 15)) * DM + h * 256 + 8 * (lane >> 4);
#pragma unroll
      for (int ds = 0; ds < 4; ++ds) { q1[ds] = *(const bf16x8*)(Qw + 32 * ds); q2[ds] = *(const bf16x8*)(Qw + 128 + 32 * ds); } }
    const bf16_t* Kh = C.Kb + h * 256; const bf16_t* Vh = C.Vb + h * 256;
    const unsigned ldsb = (unsigned)(uintptr_t)lds;
    const unsigned kdst = ldsb + (unsigned)(w >> 2) * KIMG + (unsigned)(w & 3) * 4096u, vdst = ldsb + V_OFF + (unsigned)w * 4096u;
    const LAS u32x4* offs = (const LAS u32x4*)(lds + OFFS_OFF + tid * 32);
    auto dma_piece = [&](int k, int t, int b, const u32x4& ko, const u32x4& vo) {
        if (MODE >= 3 && MODE != 4) return;
        if (k < 4) glds16(Kh + (size_t)t * 64 * DM + ko[k], RFL(kdst + (unsigned)b * KSLOT + (unsigned)k * 1024u));
        else glds16(Vh + (size_t)t * 64 * DM + vo[k - 4], RFL(vdst + (unsigned)b * VSLOT + (unsigned)(k - 4) * 1024u)); };
    const int vb0 = (int)(uintptr_t)(lds + V_OFF);
    const int NT = 2 * c + 2, myNT = NT - (w < 4 ? 1 : 0);
    float m1 = 0.f, l1 = 0.f, m2 = 0.f, l2 = 0.f, al1 = 1.f, al2 = 1.f; f32x4 o1[16], o2[16]; f32x4 s[4]; bf16x8 pa1[2], pa2[2];
#pragma unroll
    for (int cb = 0; cb < 16; ++cb) { o1[cb] = (f32x4){0.f, 0.f, 0.f, 0.f}; o2[cb] = (f32x4){0.f, 0.f, 0.f, 0.f}; }
    { const u32x4 ko = offs[0], vo = offs[1];
#pragma unroll
      for (int k = 0; k < 8; ++k) dma_piece(k, 0, 0, ko, vo); }
    WAIT_BAR(0);
    for (int j = 0; j < NT; ++j) {
        const bool more = j + 1 < NT;
        const u32x4 ko = offs[0], vo = offs[1];
        auto fill = [&](int k) { if (more) dma_piece(k, j + 1, (j + 1) & 1, ko, vo); };
        if (j < myNT && MODE != 4 && MODE != 7) {
            if (MODE != 6) {
            scores(s, lds + (j & 1) * KSLOT, R, q1, m1); fill(0); fill(1); softmax(s, m1, l1, al1, pa1, j == 0); fill(2); fill(3);
            scores(s, lds + (j & 1) * KSLOT + KIMG, R, q2, m2); fill(4); fill(5); softmax(s, m2, l2, al2, pa2, j == 0); fill(6); fill(7);
            if (__any(al1 < 1.f)) ATT_SCALE(o1, al1);
            if (__any(al2 < 1.f)) ATT_SCALE(o2, al2); }
            else { _Pragma("unroll") for (int k = 0; k < 8; ++k) fill(k); }
            if (MODE != 5) pv2(o1, o2, vb0 + (j & 1) * VSLOT, R, pa1, pa2, NoFill{});
        } else {
#pragma unroll
            for (int k = 0; k < 8; ++k) fill(k);
        }
        WAIT_BAR(0);
    }
    finish_rows(C, o1, o2, l1, l2, 128 * c + 16 * w + (lane & 15), h, lane);
}

__device__ __forceinline__ void sample_unit(const Ctx& C, LAS unsigned char* lds, int b, int h, int tid) {
    const int w = __builtin_amdgcn_readfirstlane(tid >> 6), lane = tid & 63;
    const int row0 = MP + DS * b;
    if ((w & 3) >= 2) {
        const int lt = (((w >> 2) << 1) | (w & 1)) * 64 + lane, sr = lt >> 4, sc = (lt & 15) * 8;
        const float* kp = C.ck + (((size_t)b * PAST + sr) * NH + h) * 256 + sc; const float* vp = C.cv + (((size_t)b * PAST + sr) * NH + h) * 256 + sc;
        constexpr size_t RS = (size_t)NH * 256;
        f32x8 kf[8], vf[8];
#define LLOAD(t) do { const size_t ro = (size_t)(t) * 64 * RS; _Pragma("unroll") for (int i = 0; i < 4; ++i) { kf[2 * i] = *(const f32x8*)(kp + ro + (size_t)(16 * i) * RS); kf[2 * i + 1] = *(const f32x8*)(kp + ro + (size_t)(16 * i) * RS + 128); \
            vf[2 * i] = *(const f32x8*)(vp + ro + (size_t)(16 * i) * RS); vf[2 * i + 1] = *(const f32x8*)(vp + ro + (size_t)(16 * i) * RS + 128); } } while (0)
        LLOAD(0);
        for (int t = 0; t < 32; ++t) {
            LAS unsigned char* Kd = lds + (t & 1) * KSLOT; LAS unsigned char* Vd = lds + V_OFF + (t & 1) * VSLOT;
#pragma unroll
            for (int i = 0; i < 4; ++i) { const int kr = sr + 16 * i;
                *(LAS bf16x8*)(Kd + k_st(kr, sc >> 3)) = tobf(kf[2 * i]); *(LAS bf16x8*)(Kd + KIMG + k_st(kr, sc >> 3)) = tobf(kf[2 * i + 1]);
                *(LAS bf16x8*)(Vd + v_st(kr, sc >> 3)) = tobf(vf[2 * i]); *(LAS bf16x8*)(Vd + v_st(kr, 16 + (sc >> 3))) = tobf(vf[2 * i + 1]); }
            if (t + 1 < 32) LLOAD(t + 1);
            __syncthreads();
        }
#undef LLOAD
        { LAS unsigned char* Kd = lds; LAS unsigned char* Vd = lds + V_OFF;
#pragma unroll
          for (int i = 0; i < 4; ++i) { const int kr = sr + 16 * i; const bf16_t* ks = C.Kb + (size_t)(row0 + kr) * DM + h * 256 + sc; const bf16_t* vs = C.Vb + (size_t)(row0 + kr) * DM + h * 256 + sc;
              bf16x8 k0 = *(const bf16x8*)ks, k1 = *(const bf16x8*)(ks + 128), v0 = *(const bf16x8*)vs, v1 = *(const bf16x8*)(vs + 128);
              if (kr >= DS) { v0 = bf16x8{}; v1 = bf16x8{}; k0 = bf16x8{}; k1 = bf16x8{}; }
              *(LAS bf16x8*)(Kd + k_st(kr, sc >> 3)) = k0; *(LAS bf16x8*)(Kd + KIMG + k_st(kr, sc >> 3)) = k1;
              *(LAS bf16x8*)(Vd + v_st(kr, sc >> 3)) = v0; *(LAS bf16x8*)(Vd + v_st(kr, 16 + (sc >> 3))) = v1; } }
        __syncthreads();
    } else if ((w & 3) == 0) {
        const int n = w >> 2;
        Rd R; make_rd(R, lane);
        bf16x8 q[4];
        { const bf16_t* Qw = C.Qb + (size_t)(row0 + (lane & 15)) * DM + h * 256 + 128 * n + 8 * (lane >> 4);
#pragma unroll
          for (int ds = 0; ds < 4; ++ds) q[ds] = *(const bf16x8*)(Qw + 32 * ds); }
        const int vb0 = (int)(uintptr_t)(lds + V_OFF);
        float m = 0.f, l = 0.f, al; f32x4 o[16]; f32x4 s[4]; bf16x8 pa[2];
#pragma unroll
        for (int cb = 0; cb < 16; ++cb) o[cb] = (f32x4){0.f, 0.f, 0.f, 0.f};
        for (int t = 0; t < 33; ++t) {
            __syncthreads();
            scores(s, lds + (t & 1) * KSLOT + n * KIMG, R, q, m);
            if (t == 32) {
#pragma unroll
                for (int kb = 0; kb < 4; ++kb) if (kb >= 2 || (lane >> 4) >= 2) s[kb] = (f32x4){-1e30f, -1e30f, -1e30f, -1e30f}; }
            softmax(s, m, l, al, pa, t == 0);
            if (__any(al < 1.f)) ATT_SCALE(o, al);
            pv1(o, vb0 + (t & 1) * VSLOT, R, pa);
        }
        const float f = (n == 0 ? 1.f : -C.lam) / l;
        ATT_SCALE(o, f);
        LAS float* X = (LAS float*)lds;
        __syncthreads();
        if (n == 1) {
#pragma unroll
            for (int cb = 0; cb < 16; ++cb) *(LAS f32x4*)(X + (cb * 64 + lane) * 4) = o[cb]; }
        __syncthreads();
        if (n == 0) {
            int g = lane >> 4; asm volatile("" : "+v"(g)); float ss = 0.f;
#pragma unroll
            for (int cb = 0; cb < 16; ++cb) { o[cb] += *(const LAS f32x4*)(X + (cb * 64 + lane) * 4); ss += (o[cb][0] * o[cb][0] + o[cb][1] * o[cb][1]) + (o[cb][2] * o[cb][2] + o[cb][3] * o[cb][3]); }
            ss = grp_sum(ss);
            const float rr = (1.0f / sqrtf(ss * (1.0f / 256.0f) + EPS)) * (1.0f - LAMBDA_INIT);
            const size_t rowoff = (size_t)(row0 + (lane & 15)) * DM + h * 256 + 4 * g;
#pragma unroll
            for (int cb = 0; cb < 16; ++cb) { const f32x4 sg = *(const f32x4*)(C.subln + 16 * cb + 4 * g); const u32x2 z = *(const u32x2*)(C.SZ2 + rowoff + 16 * cb);
                u32x2 ov; ov.x = pk2(o[cb][0] * rr * sg[0] * bflo(z.x), o[cb][1] * rr * sg[1] * bfhi(z.x)); ov.y = pk2(o[cb][2] * rr * sg[2] * bflo(z.y), o[cb][3] * rr * sg[3] * bfhi(z.y));
                *(u32x2*)(C.Ab + rowoff + 16 * cb) = ov; } }
    } else {
        for (int t = 0; t < 33; ++t) __syncthreads();
    }
    if ((w & 3) != 0) { __syncthreads(); __syncthreads(); }
    __syncthreads();
}
#undef WAIT_BAR
#undef RFL
#undef ATT_SCALE
}

constexpr int CW_ATTQ = 2048;
constexpr int ATT_PER_HEAD = 64 + DB;
__device__ __forceinline__ void att_decode(int pos, bool& samp, int& a) {
    if (pos < 64) { samp = pos & 1; a = samp ? (pos >> 1) : 63 - (pos >> 1); return; }
    samp = false; a = 63 - (32 + (pos - 64));
}
template <int MODE> __device__ __forceinline__ void p6_attn(Frame& F, const Args& a, int rep) {
    unsigned char* ws = a.ws;
    att::Ctx C{(const bf16_t*)(ws + WS_QB), (const bf16_t*)(ws + WS_KB), (const bf16_t*)(ws + WS_VB), (const bf16_t*)(ws + WS_SZ2), (bf16_t*)(ws + WS_AB), a.in[4], a.in[5], a.in[26], ((const float*)(ws + WS_SMALL + SM_LAM))[0]};
    volatile LAS int* qw = (volatile LAS int*)(F.lds + att::Q_OFF);
    { const int w = F.wave, lane = F.lane; u32x4 ko, vo;
#pragma unroll
      for (int pc = 0; pc < 4; ++pc) { { const int L = (4 * (w & 3) + pc) * 1024 + lane * 16, row = L >> 8, cc = (lane & 15) ^ att::fK(row); ko[pc] = (unsigned)row * DM + 128 * (w >> 2) + 8 * cc; }
          { const int L = (4 * w + pc) * 1024 + lane * 16, row = L >> 9, cc = ((L >> 4) & 31) ^ att::xV(row); vo[pc] = (unsigned)row * DM + 8 * cc; } }
      LAS u32x4* o = (LAS u32x4*)(F.lds + att::OFFS_OFF + F.tid * 32); o[0] = ko; o[1] = vo; }
    __syncthreads();
    const int x = (int)(xb_xcc_id() & 7u);
    for (int k = 0; k < NH; ++k) {
        const int h = (x + k) & 7;
        for (;;) {
            if (F.tid == 0) *qw = (int)__hip_atomic_fetch_add((unsigned*)(F.ctl + CW_ATTQ + (rep * NH + h) * 16), 1u, __ATOMIC_RELAXED, __HIP_MEMORY_SCOPE_AGENT);
            __syncthreads();
            const int pos = *qw;
            __syncthreads();
            if (pos >= ATT_PER_HEAD) break;
            bool samp; int ua; att_decode(pos, samp, ua);
            if ((MODE != 0 && MODE != 2 && samp) || (MODE == 2 && !samp)) continue;
            if (samp) att::sample_unit(C, F.lds, ua, h, F.tid); else att::prompt_unit<MODE>(C, F.lds, ua, h, F.tid);
        }
    }
}

template <bool PERM5> __device__ __forceinline__ void p0_transpose_item(const float* W, const float* g, int K, int N, bf16_t* WT, int row_off, LAS float* scr, int item, int lane) {
    const int nblk = N / 64, kb = item / nblk, nb = item % nblk, k0 = 32 * kb, n0 = 64 * nb;
    f32x4 v[8];
#pragma unroll
    for (int i = 0; i < 8; ++i) v[i] = *(const f32x4*)(W + (size_t)(k0 + 4 * i + (lane >> 4)) * N + n0 + 4 * (lane & 15));
#pragma unroll
    for (int i = 0; i < 8; ++i) *(LAS f32x4*)(scr + (4 * i + (lane >> 4)) * 68 + 4 * (lane & 15)) = v[i];
    const int c = lane & 3;
    f32x4 g0 = (f32x4){1.f, 1.f, 1.f, 1.f}, g1 = g0;
    if (g) { g0 = *(const f32x4*)(g + k0 + 8 * c); g1 = *(const f32x4*)(g + k0 + 8 * c + 4); }
    LDS_WAIT(); asm volatile("" ::: "memory");
#pragma unroll
    for (int j = 0; j < 4; ++j) { const int n = (lane >> 2) + 16 * j; const LAS float* s = scr + (8 * c) * 68 + n;
        u32x4 o; o.x = pk2(s[0 * 68] * g0[0], s[1 * 68] * g0[1]); o.y = pk2(s[2 * 68] * g0[2], s[3 * 68] * g0[3]); o.z = pk2(s[4 * 68] * g1[0], s[5 * 68] * g1[1]); o.w = pk2(s[6 * 68] * g1[2], s[7 * 68] * g1[3]);
        const int row = row_off + (PERM5 ? wt5_row(n0 + n) : n0 + n);
        *(u32x4*)(WT + (size_t)row * K + k0 + 8 * c) = o; }
    LDS_WAIT(); asm volatile("" ::: "memory");
}
__device__ __forceinline__ void p0_row(const float* xrow, bf16_t* orow, float* rs, int lane) {
    const f32x4* xr = (const f32x4*)xrow + lane;
    f32x4 v[8]; float s = 0.f;
#pragma unroll
    for (int j = 0; j < 8; ++j) { v[j] = xr[64 * j]; s += (v[j].x * v[j].x + v[j].y * v[j].y) + (v[j].z * v[j].z + v[j].w * v[j].w); }
    s = wave_sum(s);
    if (lane == 0) *rs = 1.0f / sqrtf(s * (1.0f / DM) + EPS);
    unsigned long long* o8 = (unsigned long long*)orow + lane;
#pragma unroll
    for (int j = 0; j < 8; ++j) o8[64 * j] = (unsigned long long)pk2(v[j].x, v[j].y) | ((unsigned long long)pk2(v[j].z, v[j].w) << 32);
}
__device__ __forceinline__ void p0_prologue(Frame& F, const Args& a) {
    unsigned char* ws = a.ws;
    LAS float* scr = (LAS float*)(F.lds + RING_OFF + F.wave * 16384);
    const int gw = F.vcu * NWAVES + F.wave, NGW = F.G * NWAVES;
    bf16_t *Wt1 = (bf16_t*)(ws + WS_WT1), *Wtg = (bf16_t*)(ws + WS_WTG), *Wto = (bf16_t*)(ws + WS_WTO), *Wt5 = (bf16_t*)(ws + WS_WT5), *Wtb = (bf16_t*)(ws + WS_WTB);
    constexpr int I_BIG = (DM / 32) * (4096 / 64), I_SQ = (DM / 32) * (DM / 64);
    constexpr int NITEMS = 3 * I_BIG + 3 * I_SQ;
    for (int it = gw; it < NITEMS; it += NGW) {
        int r = it;
        if (r < I_BIG) { p0_transpose_item<false>(a.in[7], a.in[6], DM, 4096, Wt1, 0, scr, r, F.lane); continue; } r -= I_BIG;
        if (r < I_BIG) { p0_transpose_item<true>(a.in[19], a.in[18], DM, 4096, Wt5, 0, scr, r, F.lane); continue; } r -= I_BIG;
        if (r < I_BIG) { p0_transpose_item<true>(a.in[21], a.in[20], DM, 4096, Wt5, 4096, scr, r, F.lane); continue; } r -= I_BIG;
        if (r < I_SQ) { p0_transpose_item<false>(a.in[16], nullptr, DM, DM, Wtg, 0, scr, r, F.lane); continue; } r -= I_SQ;
        if (r < I_SQ) { p0_transpose_item<false>(a.in[17], nullptr, DM, DM, Wto, 0, scr, r, F.lane); continue; } r -= I_SQ;
        p0_transpose_item<false>(a.in[27], nullptr, DM, DM, Wtb, 0, scr, r, F.lane);
    }
    for (int it = gw; it < NG * 16; it += NGW) p0_ssm_item(a, it >> 4, it & 15, scr, F.lane);
    bf16_t* Xb = (bf16_t*)(ws + WS_XB); float* rs0 = (float*)(ws + WS_RS0);
    for (int m = gw; m < M; m += NGW) p0_row(m < MP ? a.in[0] + (size_t)m * DM : a.in[1] + (size_t)(m - MP) * DM, Xb + (size_t)m * DM, rs0 + m, F.lane);
    const int gt = F.vcu * (NWAVES * 64) + F.tid, NGT = F.G * NWAVES * 64;
    float* lam = (float*)(ws + WS_SMALL + SM_LAM);
    { float* z1 = (float*)(ws + WS_SSQ1) + (size_t)MP * NSSQ; float* z2 = (float*)(ws + WS_SSQ2) + (size_t)MP * NSSQ;
      for (int i = gt; i < MS * NSSQ; i += NGT) { z1[i] = 0.f; z2[i] = 0.f; } }
    float* rope = (float*)(ws + WS_ROPE);
    for (int idx = gt; idx < SEQ * 64; idx += NGT) {
        const int pos = idx >> 6, i = idx & 63;
        const float inv = (float)pow(10000.0, -(double)(2 * i) / 128.0);
        const float ang = (float)pos * inv;
        rope[idx] = (float)cos((double)ang); rope[(size_t)SEQ * 64 + idx] = (float)sin((double)ang);
    }
    if (blockIdx.x == 0 && F.tid == 0) { float s1 = 0.f, s2 = 0.f; for (int i = 0; i < HD; ++i) { s1 += a.in[22][i] * a.in[23][i]; s2 += a.in[24][i] * a.in[25][i]; } lam[0] = expf(s1) - expf(s2) + LAMBDA_INIT; }
}
__device__ __forceinline__ void p8_final(Frame& F, const Args& a) {
    const int gw = F.vcu * NWAVES + F.wave, NGW = F.G * NWAVES;
    const float* X2 = (const float*)(a.ws + WS_X2); const float* ssq = (const float*)(a.ws + WS_SSQ2); const f32x4* gn = (const f32x4*)a.in[28] + F.lane;
    for (int m = gw; m < M; m += NGW) {
        const f32x4* xr = (const f32x4*)(X2 + (size_t)m * DM) + F.lane; f32x4* yr = (f32x4*)(a.out + O_YP + (size_t)m * DM) + F.lane;
        float q = (F.lane < NSSQ) ? ssq[(size_t)m * NSSQ + F.lane] : 0.f; q = wave_sum(q);
        const float rs = 1.0f / sqrtf(q * (1.0f / DM) + EPS);
#pragma unroll
        for (int j = 0; j < 8; ++j) yr[64 * j] = xr[64 * j] * rs * gn[64 * j];
    }
}

template <int MODE> __global__ void __launch_bounds__(NWAVES * 64, 2) mk_fwd(Args args) {
    extern __shared__ __attribute__((aligned(16))) unsigned char lds[];
    Frame F;
    F.lds = (LAS unsigned char*)lds;
    F.MISC = (volatile LAS unsigned*)(F.lds + MISC_OFF);
    F.tid = threadIdx.x; F.lane = F.tid & 63; F.wave = __builtin_amdgcn_readfirstlane(F.tid >> 6);
    F.G = gridDim.x; { const int bx = blockIdx.x; F.vcu = (F.G % 8 == 0) ? (bx % 8) * (F.G / 8) + bx / 8 : bx; }
    unsigned char* ws = args.ws;
    F.ctl = (gu32*)(ws + WS_CTL);
    for (int u = F.tid; u < (LDS_BYTES - LDSCTL_OFF) / 4; u += NWAVES * 64) ((LAS unsigned*)(F.lds + LDSCTL_OFF))[u] = 0u;
    __syncthreads();
    XcdBarrier bar = xcd_barrier_post((unsigned*)(F.ctl + CW_BAR) + args.li * XCD_BAR_WORDS, F.MISC + 8);
    const int lo = args.ph_lo, hi = args.ph_hi;
#define IN(k) (lo <= (k) && (k) < hi)
#define REFRESH() do { int t_ = threadIdx.x; asm volatile("" : "+v"(t_)); F.tid = t_; F.lane = t_ & 63; } while (0)
#define BOTH(k) (IN(k) && IN((k) + 1))
    bf16_t *Wt1 = (bf16_t*)(ws + WS_WT1), *Wtg = (bf16_t*)(ws + WS_WTG), *Wto = (bf16_t*)(ws + WS_WTO), *Wt5 = (bf16_t*)(ws + WS_WT5), *Wtb = (bf16_t*)(ws + WS_WTB);
    bf16_t *Xb = (bf16_t*)(ws + WS_XB), *Ub = (bf16_t*)(ws + WS_UB), *SZ = (bf16_t*)(ws + WS_SZ), *Yg = (bf16_t*)(ws + WS_YG), *Ob = (bf16_t*)(ws + WS_OB), *X1b = (bf16_t*)(ws + WS_X1B),
           *Kb = (bf16_t*)(ws + WS_KB), *Vb = (bf16_t*)(ws + WS_VB), *Qb = (bf16_t*)(ws + WS_QB), *SZ2 = (bf16_t*)(ws + WS_SZ2), *Ab = (bf16_t*)(ws + WS_AB);
    float *X1 = (float*)(ws + WS_X1), *X2 = (float*)(ws + WS_X2), *ssq1 = (float*)(ws + WS_SSQ1), *ssq2 = (float*)(ws + WS_SSQ2);

    if (IN(0)) { REFRESH(); p0_prologue(F, args); if (BOTH(0)) xcd_barrier(bar); }
    if (IN(1)) { REFRESH();
        pg8::Gemm g{Xb, Wt1, MP, 4096, DM}; pg8::StaticOrder S; S.init(MP, 4096, F.G, (int)blockIdx.x);
        pg8::EpiUZ E{Ub, SZ, (const float*)(ws + WS_RS0)};
        pg8::gemm_phase<pg8::EpiUZ, pg8::StaticOrder, true, true>(F.lds + RING_OFF, g, S, E);
        sk::phase<4, 64>(F.lds + RING_OFF, Xb, Wt1, 4096, sk::EpiUZ{Ub, SZ, (const float*)(ws + WS_RS0)}, F.vcu, F.G);
        if (BOTH(1)) xcd_barrier(bar);
    }
    if (IN(2)) { REFRESH(); p2_ssm(F, args); if (BOTH(2)) xcd_barrier(bar); }
    if (IN(3)) { REFRESH();
        pg8::Gemm g{Yg, Wtg, MP, DM, DM}; pg8::StaticOrder S; S.init(MP, DM, F.G, (int)blockIdx.x);
        pg8::EpiGlu E{Yg, SZ, Ob};
        pg8::gemm_phase<pg8::EpiGlu, pg8::StaticOrder, true, true>(F.lds + RING_OFF, g, S, E);
        sk::phase<4, 32>(F.lds + RING_OFF, Yg, Wtg, DM, sk::EpiGlu{Yg, SZ, Ob}, F.vcu, F.G);
        if (BOTH(3)) xcd_barrier(bar);
    }
    if (IN(4)) { REFRESH();
        pg8::Gemm g{Ob, Wto, MP, DM, DM}; pg8::StaticOrder S; S.init(MP, DM, F.G, (int)blockIdx.x);
        pg8::EpiRes E{args.in[0], args.in[1], X1, X1b, ssq1};
        pg8::gemm_phase<pg8::EpiRes, pg8::StaticOrder, true, true>(F.lds + RING_OFF, g, S, E);
        sk::phase<4, 32>(F.lds + RING_OFF, Ob, Wto, DM, sk::EpiRes{args.in[1] - (size_t)MP * DM, X1, X1b, ssq1}, F.vcu, F.G);
        if (BOTH(4)) xcd_barrier(bar);
    }
    if (IN(5)) { REFRESH();
        pg8::Gemm g{X1b, Wt5, MP, 8192, DM}; pg8::StaticOrder S; S.init(MP, 8192, F.G, (int)blockIdx.x);
        pg8::EpiKVQZ E{ssq1, (const float*)(ws + WS_ROPE), args.out, Kb, Vb, Qb, SZ2};
        pg8::gemm_phase<pg8::EpiKVQZ, pg8::StaticOrder, true, true>(F.lds + RING_OFF, g, S, E);
        sk::phase<8, 64>(F.lds + RING_OFF, X1b, Wt5, 8192, sk::EpiKVQZ{ssq1, (const float*)(ws + WS_ROPE), args.out, Kb, Vb, Qb, SZ2}, F.vcu, F.G);
        if (BOTH(5)) xcd_barrier(bar);
    }
    if (IN(6)) { REFRESH(); p6_attn<MODE>(F, args, args.li); if (BOTH(6)) xcd_barrier(bar); }
    if (IN(7)) { REFRESH();
        pg8::Gemm g{Ab, Wtb, MP, DM, DM}; pg8::StaticOrder S; S.init(MP, DM, F.G, (int)blockIdx.x);
        pg8::EpiRes E{X1, X1 + (size_t)MP * DM, X2, nullptr, ssq2};
        pg8::gemm_phase<pg8::EpiRes, pg8::StaticOrder, true, true>(F.lds + RING_OFF, g, S, E);
        sk::phase<4, 32>(F.lds + RING_OFF, Ab, Wtb, DM, sk::EpiRes{X1, X2, nullptr, ssq2}, F.vcu, F.G);
        if (BOTH(7)) xcd_barrier(bar);
    }
    if (IN(8)) { REFRESH(); p8_final(F, args); }
#undef IN
#undef BOTH
}

static void launch_mk(int grid, const Args& base, int lo, int hi, int li, hipStream_t stream, int mode = 0) {
    Args a = base; a.ph_lo = lo; a.ph_hi = hi; a.li = li; a.pad = mode;
#ifdef MK_PROBE_MODE
    if (mode == MK_PROBE_MODE) { (void)hipFuncSetAttribute((const void*)mk_fwd<MK_PROBE_MODE>, hipFuncAttributeMaxDynamicSharedMemorySize, LDS_BYTES); hipLaunchKernelGGL(mk_fwd<MK_PROBE_MODE>, dim3(grid), dim3(NWAVES * 64), LDS_BYTES, stream, a); } else
#endif
    hipLaunchKernelGGL(mk_fwd<0>, dim3(grid), dim3(NWAVES * 64), LDS_BYTES, stream, a);
    const hipError_t le = hipPeekAtLastError();
    if (le != hipSuccess) fprintf(stderr, "kernel_launch: launch [%d,%d) failed: %s (grid %d)\n", lo, hi, hipGetErrorName(le), grid);
}
extern "C" void kernel_launch(void* const* d_in, const int* in_sizes, int n_in, void* d_out, int out_size, void* d_ws, size_t ws_size, hipStream_t stream) {
    static int grid = 0;
    if (grid == 0) {
        if (n_in != 29 || (size_t)out_size != O_END || ws_size < WS_END2) { fprintf(stderr, "kernel_launch: unexpected shapes (n_in %d out %d ws %zu)\n", n_in, out_size, ws_size); grid = -1; return; }
        int dev = 0, cus = 0, per_cu = 0;
        if (hipGetDevice(&dev) != hipSuccess || hipDeviceGetAttribute(&cus, hipDeviceAttributeMultiprocessorCount, dev) != hipSuccess) { grid = -1; return; }
        if (hipFuncSetAttribute((const void*)mk_fwd<0>, hipFuncAttributeMaxDynamicSharedMemorySize, LDS_BYTES) != hipSuccess) { fprintf(stderr, "kernel_launch: hipFuncSetAttribute failed\n"); grid = -1; return; }
        if (hipOccupancyMaxActiveBlocksPerMultiprocessor(&per_cu, (const void*)mk_fwd<0>, NWAVES * 64, LDS_BYTES) != hipSuccess || per_cu < 1) { fprintf(stderr, "kernel_launch: occupancy query says %d blocks per CU\n", per_cu); per_cu = 1; }
        (void)hipGetLastError();
        grid = cus;
        if (grid < 2 * NG) { fprintf(stderr, "kernel_launch: %d CUs: the S5 phase deals one (group, half) item per workgroup and needs %d; nothing launched\n", grid, 2 * NG); grid = -1; return; }
        if (grid > 2 * NG) grid = 2 * NG;
    }
    if (grid < 0) return;
    if (hipMemsetAsync((char*)d_ws + WS_CTL, 0, CTL_ZERO_BYTES, stream) != hipSuccess) { fprintf(stderr, "kernel_launch: memset failed\n"); return; }
    Args a{};
    for (int i = 0; i < 29; ++i) a.in[i] = (const float*)d_in[i];
    a.out = (float*)d_out; a.ws = (unsigned char*)d_ws;
    launch_mk(grid, a, 0, 9, 0, stream);
#ifdef MK_PROBE_PHASES
    { const int extra[] = {MK_PROBE_PHASES}; int li = 1;
      for (int k : extra) { launch_mk(grid, a, k % 100, k % 100 + 1, li, stream, k / 100); ++li; } }
#endif
}
```
